# Optimizing an MI355X kernel written in HIP

```python
import math
import jax
import jax.numpy as jnp
from jax import lax
import numpy as np

D_MODEL = 1024
BATCH = 4
SEQ = 4096
DEPTH = 1

D_MIX = D_MODEL
D_S5 = D_MIX // 2
S5_GROUP = 16
N_S5_GROUPS = D_S5 // S5_GROUP
S5_STATE = 64
D_GDN = D_MIX - D_S5
GDN_HEAD_DIM = 128
N_GDN_HEADS = D_GDN // GDN_HEAD_DIM
CONV_WIDTH = 4
CHUNK = 64
D_IN = D_S5 + 4 * D_GDN + 2 * N_GDN_HEADS
N_EXPERT_GROUPS = 4
EXPERTS_PER_GROUP = 8
N_EXPERTS = N_EXPERT_GROUPS * EXPERTS_PER_GROUP
TOP_K_IN_GROUP = 2
D_EXPERT = D_MODEL // 4
N_MOD = 6
EPS = 1e-6

kernel_name = 'hymba_s5_gdn_hmoe_adaln_block'


def rmsnorm(x, g):
    x32 = x.astype(jnp.float32)
    y = x32 * lax.rsqrt(jnp.mean(x32 * x32, axis=-1, keepdims=True) + EPS)
    return (y * g.astype(jnp.float32)).astype(x.dtype)


def l2norm(x):
    return x * lax.rsqrt(jnp.sum(x * x, axis=-1, keepdims=True) + EPS)


def modulate(h, shift, scale):
    return h * (1.0 + scale[:, None, :]) + shift[:, None, :]


def _linear_recurrence_combine(e1, e2):
    a1, b1 = e1
    a2, b2 = e2
    return a1 * a2, a2 * b1 + b2


def s5_mixer(u, lam_re, lam_im, log_step, b_re, b_im, c_re, c_im, d_skip, w_glu, b_glu):
    f32 = jnp.float32
    bsz, seq, _ = u.shape
    u32 = u.astype(f32)
    ug = u32.reshape(bsz, seq, N_S5_GROUPS, S5_GROUP)
    lam = lax.complex(lam_re.astype(f32), lam_im.astype(f32))
    step = jnp.exp(log_step.astype(f32))[:, None]
    lam_bar = jnp.exp(lam * step)
    b_c = lax.complex(b_re.astype(f32), b_im.astype(f32))
    b_bar = ((lam_bar - 1.0) / lam)[..., None] * b_c
    bu = lax.complex(jnp.einsum('gph,blgh->blgp', b_bar.real, ug),
                     jnp.einsum('gph,blgh->blgp', b_bar.imag, ug))
    a = jnp.broadcast_to(lam_bar, bu.shape)
    _, states = lax.associative_scan(_linear_recurrence_combine, (a, bu), axis=1)
    c_c = lax.complex(c_re.astype(f32), c_im.astype(f32))
    y = jnp.einsum('ghp,blgp->blgh', c_c, states).real.reshape(bsz, seq, D_S5)
    y = y + d_skip.astype(f32) * u32
    y = jax.nn.gelu(y)
    y = y * jax.nn.sigmoid(y @ w_glu.astype(f32) + b_glu.astype(f32))
    return y.astype(u.dtype)


def causal_depthwise_conv(x, w):
    k, ch = w.shape
    return lax.conv_general_dilated(x, w[:, None, :], window_strides=(1,),
                                    padding=[(k - 1, 0)],
                                    dimension_numbers=('NWC', 'WIO', 'NWC'),
                                    feature_group_count=ch)


def gated_delta_rule(q, k, v, g, beta):
    bsz, nh, seq, dk = q.shape
    dv = v.shape[-1]
    n_chunks = seq // CHUNK
    q = q.reshape(bsz, nh, n_chunks, CHUNK, dk)
    k = k.reshape(bsz, nh, n_chunks, CHUNK, dk)
    v = v.reshape(bsz, nh, n_chunks, CHUNK, dv)
    beta = beta.reshape(bsz, nh, n_chunks, CHUNK)
    g = jnp.cumsum(g.reshape(bsz, nh, n_chunks, CHUNK), axis=-1)
    idx = jnp.arange(CHUNK)
    causal = idx[:, None] >= idx[None, :]
    strict = idx[:, None] > idx[None, :]
    decay = jnp.exp(jnp.where(causal, g[..., :, None] - g[..., None, :], -jnp.inf))
    k_beta = k * beta[..., None]
    v_beta = v * beta[..., None]
    kkt = jnp.einsum('bhncd,bhnsd->bhncs', k_beta, k) * decay
    a_mat = jnp.where(strict, kkt, 0.0) + jnp.eye(CHUNK, dtype=q.dtype)
    rhs = jnp.concatenate([v_beta, k_beta * jnp.exp(g)[..., None]], axis=-1)
    sol = lax.linalg.triangular_solve(a_mat, rhs, left_side=True, lower=True,
                                      unit_diagonal=True)
    value, k_cumdecay = sol[..., :dv], sol[..., dv:]
    qk = jnp.einsum('bhncd,bhnsd->bhncs', q, k) * decay
    q_decay = q * jnp.exp(g)[..., None]
    k_tail = k * jnp.exp(g[..., -1:] - g)[..., None]
    g_last = jnp.exp(g[..., -1])

    def chunk_step(state, inp):
        qk_i, qd_i, kc_i, val_i, kt_i, gl_i = inp
        v_new = val_i - jnp.einsum('bhcd,bhde->bhce', kc_i, state)
        o_i = (jnp.einsum('bhcd,bhde->bhce', qd_i, state)
               + jnp.einsum('bhcs,bhse->bhce', qk_i, v_new))
        state = state * gl_i[..., None, None] + jnp.einsum('bhcd,bhce->bhde', kt_i, v_new)
        return state, o_i

    xs = tuple(jnp.moveaxis(t, 2, 0) for t in (qk, q_decay, k_cumdecay, value, k_tail, g_last))
    state0 = jnp.zeros((bsz, nh, dk, dv), q.dtype)
    _, o = lax.scan(chunk_step, state0, xs)
    return jnp.moveaxis(o, 0, 2).reshape(bsz, nh, seq, dv)


def gdn_mixer(qkv, z, a_gate, b_gate, conv_w, a_log, dt_bias, gdn_norm_g):
    f32 = jnp.float32
    bsz, seq, _ = qkv.shape
    qkv = jax.nn.silu(causal_depthwise_conv(qkv, conv_w)).astype(f32)
    q, k, v = jnp.split(qkv, 3, axis=-1)

    def heads(t):
        return t.reshape(bsz, seq, N_GDN_HEADS, GDN_HEAD_DIM).transpose(0, 2, 1, 3)

    q = l2norm(heads(q)) * (GDN_HEAD_DIM ** -0.5)
    k = l2norm(heads(k))
    v = heads(v)
    beta = jax.nn.sigmoid(b_gate.astype(f32)).transpose(0, 2, 1)
    g = (-jnp.exp(a_log.astype(f32))
         * jax.nn.softplus(a_gate.astype(f32) + dt_bias.astype(f32))).transpose(0, 2, 1)
    o = gated_delta_rule(q, k, v, g, beta).transpose(0, 2, 1, 3)
    zh = z.astype(f32).reshape(bsz, seq, N_GDN_HEADS, GDN_HEAD_DIM)
    o = rmsnorm(o, gdn_norm_g) * jax.nn.silu(zh)
    return o.reshape(bsz, seq, D_GDN).astype(z.dtype)


def hybrid_mixer(h, w_in, lam_re, lam_im, log_step, s5_b_re, s5_b_im, s5_c_re, s5_c_im,
                 s5_d, w_glu, b_glu, conv_w, a_log, dt_bias, gdn_norm_g, w_out):
    proj = h @ w_in
    splits = [D_S5, D_S5 + 3 * D_GDN, D_S5 + 4 * D_GDN, D_S5 + 4 * D_GDN + N_GDN_HEADS]
    u_s5, qkv, z, a_gate, b_gate = jnp.split(proj, splits, axis=-1)
    y_s5 = s5_mixer(u_s5, lam_re, lam_im, log_step, s5_b_re, s5_b_im, s5_c_re, s5_c_im,
                    s5_d, w_glu, b_glu)
    y_gdn = gdn_mixer(qkv, z, a_gate, b_gate, conv_w, a_log, dt_bias, gdn_norm_g)
    return jnp.concatenate([y_s5, y_gdn], axis=-1) @ w_out


def hier_moe(h, w_router_grp, w_router_exp, w_gate, w_up, w_down):
    f32 = jnp.float32
    bsz, seq, d = h.shape
    hf = h.reshape(bsz * seq, d)
    grp_logits = (hf @ w_router_grp).astype(f32)
    grp_prob = jax.nn.softmax(grp_logits, axis=-1)
    grp_idx = jnp.argmax(grp_logits, axis=-1)
    grp_onehot = jax.nn.one_hot(grp_idx, N_EXPERT_GROUPS, dtype=f32)
    p_grp = jnp.sum(grp_prob * grp_onehot, axis=-1)
    exp_logits = (hf @ w_router_exp).astype(f32).reshape(-1, N_EXPERT_GROUPS, EXPERTS_PER_GROUP)
    sel_logits = jnp.einsum('tg,tge->te', grp_onehot, exp_logits)
    top_val, top_idx = lax.top_k(sel_logits, TOP_K_IN_GROUP)
    w_k = jax.nn.softmax(top_val, axis=-1) * p_grp[:, None]
    expert_id = grp_idx[:, None] * EXPERTS_PER_GROUP + top_idx
    combine = jnp.einsum('tk,tke->te', w_k,
                         jax.nn.one_hot(expert_id, N_EXPERTS, dtype=f32)).astype(h.dtype)

    def expert_step(acc, ws):
        wg, wu, wd, gate_col = ws
        y = (jax.nn.silu(hf @ wg) * (hf @ wu)) @ wd
        return acc + gate_col[:, None] * y, None

    acc0 = jnp.zeros_like(hf)
    out, _ = lax.scan(expert_step, acc0, (w_gate, w_up, w_down, combine.T))
    return out.reshape(bsz, seq, d)


def setup_inputs(seed: int = 0) -> dict:
    key = jax.random.key(seed)
    ks = jax.random.split(key, 32)
    f32 = jnp.float32

    def nrm(k, shape, scale):
        return jax.random.normal(k, shape, f32) * scale

    nl = DEPTH
    gp = (nl, N_S5_GROUPS, S5_STATE)
    n_idx = jnp.arange(S5_STATE, dtype=f32)
    dt_init = jnp.exp(jax.random.uniform(ks[21], (nl, N_GDN_HEADS), f32,
                                         math.log(1e-3), math.log(1e-1)))
    return {
        'x': nrm(ks[0], (BATCH, SEQ, D_MODEL), 1.0),
        'c': nrm(ks[1], (BATCH, D_MODEL), 1.0),
        'norm1_g': 1.0 + nrm(ks[2], (nl, D_MODEL), 0.02),
        'norm2_g': 1.0 + nrm(ks[3], (nl, D_MODEL), 0.02),
        'w_ada': nrm(ks[4], (nl, D_MODEL, N_MOD * D_MODEL), 0.5 * D_MODEL ** -0.5),
        'b_ada': nrm(ks[5], (nl, N_MOD * D_MODEL), 0.02),
        'w_in': nrm(ks[6], (nl, D_MODEL, D_IN), D_MODEL ** -0.5),
        'lam_re': -0.5 + nrm(ks[7], gp, 0.01),
        'lam_im': math.pi * n_idx + nrm(ks[8], gp, 0.01),
        'log_step': jax.random.uniform(ks[9], (nl, N_S5_GROUPS), f32,
                                       math.log(1e-3), math.log(1e-1)),
        's5_b_re': nrm(ks[10], (nl, N_S5_GROUPS, S5_STATE, S5_GROUP), (2 * S5_GROUP) ** -0.5),
        's5_b_im': nrm(ks[11], (nl, N_S5_GROUPS, S5_STATE, S5_GROUP), (2 * S5_GROUP) ** -0.5),
        's5_c_re': nrm(ks[12], (nl, N_S5_GROUPS, S5_GROUP, S5_STATE), S5_STATE ** -0.5),
        's5_c_im': nrm(ks[13], (nl, N_S5_GROUPS, S5_GROUP, S5_STATE), S5_STATE ** -0.5),
        's5_d': nrm(ks[14], (nl, D_S5), 0.5),
        'w_glu': nrm(ks[15], (nl, D_S5, D_S5), D_S5 ** -0.5),
        'b_glu': nrm(ks[16], (nl, D_S5), 0.02),
        'conv_w': nrm(ks[17], (nl, CONV_WIDTH, 3 * D_GDN), CONV_WIDTH ** -0.5),
        'a_log': jnp.log(jax.random.uniform(ks[18], (nl, N_GDN_HEADS), f32, 1.0, 16.0)),
        'dt_bias': dt_init + jnp.log(-jnp.expm1(-dt_init)),
        'gdn_norm_g': 1.0 + nrm(ks[19], (nl, GDN_HEAD_DIM), 0.02),
        'w_out': nrm(ks[20], (nl, D_MIX, D_MODEL), D_MIX ** -0.5),
        'w_router_grp': nrm(ks[22], (nl, D_MODEL, N_EXPERT_GROUPS), D_MODEL ** -0.5),
        'w_router_exp': nrm(ks[23], (nl, D_MODEL, N_EXPERTS), D_MODEL ** -0.5),
        'w_gate': nrm(ks[24], (nl, N_EXPERTS, D_MODEL, D_EXPERT), D_MODEL ** -0.5),
        'w_up': nrm(ks[25], (nl, N_EXPERTS, D_MODEL, D_EXPERT), D_MODEL ** -0.5),
        'w_down': nrm(ks[26], (nl, N_EXPERTS, D_EXPERT, D_MODEL), D_EXPERT ** -0.5),
        'normf_g': 1.0 + nrm(ks[27], (D_MODEL,), 0.02),
    }


def reference(x, c, norm1_g, norm2_g, w_ada, b_ada, w_in, lam_re, lam_im, log_step,
              s5_b_re, s5_b_im, s5_c_re, s5_c_im, s5_d, w_glu, b_glu, conv_w, a_log,
              dt_bias, gdn_norm_g, w_out, w_router_grp, w_router_exp, w_gate, w_up,
              w_down, normf_g):
    h = x
    c_act = jax.nn.silu(c)
    for l in range(DEPTH):
        mod = c_act @ w_ada[l] + b_ada[l]
        sh1, sc1, gt1, sh2, sc2, gt2 = jnp.split(mod, N_MOD, axis=-1)
        a_in = modulate(rmsnorm(h, norm1_g[l]), sh1, sc1)
        mix = hybrid_mixer(a_in, w_in[l], lam_re[l], lam_im[l], log_step[l], s5_b_re[l],
                           s5_b_im[l], s5_c_re[l], s5_c_im[l], s5_d[l], w_glu[l], b_glu[l],
                           conv_w[l], a_log[l], dt_bias[l], gdn_norm_g[l], w_out[l])
        h = h + gt1[:, None, :] * mix
        m_in = modulate(rmsnorm(h, norm2_g[l]), sh2, sc2)
        moe = hier_moe(m_in, w_router_grp[l], w_router_exp[l], w_gate[l], w_up[l], w_down[l])
        h = h + gt2[:, None, :] * moe
    return rmsnorm(h, normf_g)
```

```cpp
#include <hip/hip_runtime.h>
#include <cstdio>
#include <cstdint>

#ifndef MK_N_LAUNCHES
#define MK_N_LAUNCHES 1
#endif

#define LAS __attribute__((address_space(3)))
#define GAS __attribute__((address_space(1)))
typedef unsigned short bf16;
typedef short bf16x8 __attribute__((ext_vector_type(8)));
typedef float f32x4 __attribute__((ext_vector_type(4)));
typedef float f32x2 __attribute__((ext_vector_type(2)));
typedef unsigned u32x4 __attribute__((ext_vector_type(4)));
typedef unsigned u32x2 __attribute__((ext_vector_type(2)));
typedef GAS unsigned gu32;

constexpr int BATCH = 4, SEQ = 4096, D = 1024, M = BATCH * SEQ;
constexpr int D_S5 = 512, NG = 32, SP = 64, D_GDN = 512, NH = 4, HD = 128, D_IN = 2568, N_IN = 2560;
constexpr int NE = 32, DE = 256, CS = 16  , NCH = SEQ / CS  , GC = 64  ;
constexpr int KY = 384;
constexpr int CAP = 16384;
constexpr float EPS = 1e-6f;

constexpr size_t MiB = 1u << 20;
constexpr size_t WS_CTL = 0, CTL_ZERO_BYTES = 1 * MiB;
constexpr size_t WS_MOD = 1 * MiB;
constexpr size_t WS_LAM16 = 1 * MiB + 128 * 1024;
constexpr size_t WS_GL = 1 * MiB + 160 * 1024;
constexpr size_t WS_GG = 1 * MiB + 256 * 1024;
constexpr size_t WS_BETA = 1 * MiB + 512 * 1024;
constexpr size_t WS_WIN = 2 * MiB;
constexpr size_t WS_WGLU = 7 * MiB;
constexpr size_t WS_WOUT = 8 * MiB;
constexpr size_t WS_BTY = 10 * MiB;
constexpr size_t WS_WZT = 16 * MiB;
constexpr size_t WS_WGU = 18 * MiB;
constexpr size_t WS_WD = 50 * MiB;
constexpr size_t WS_AIN = 66 * MiB;
constexpr size_t WS_VALD = WS_AIN;
constexpr size_t WS_AY = 98 * MiB;
constexpr size_t WS_ACT = WS_AY;
constexpr size_t WS_QKV = 122 * MiB;
constexpr size_t WS_O = 122 * MiB;
constexpr size_t WS_YG = 154 * MiB;
constexpr size_t WS_Z = 170 * MiB;
constexpr size_t WS_YSLOT = 122 * MiB;
constexpr size_t WS_CHA = 186 * MiB;
constexpr size_t WS_LTOK = 242 * MiB;
constexpr size_t WS_LW = 244 * MiB;
constexpr size_t WS_DUMP = 246 * MiB;
constexpr size_t WS_END = 256 * MiB;
constexpr int CHA_BYTES = 57344;
constexpr int CW_BAR = 4096;
constexpr int CW_CNT = 8192;

constexpr int LDS_BYTES = 163840;
constexpr int MISC_OFF = LDS_BYTES - 1024;

#define LDS_WAIT() asm volatile("s_waitcnt lgkmcnt(0)" ::: "memory")
#define VM_WAIT() asm volatile("s_waitcnt vmcnt(0)" ::: "memory")
__device__ __forceinline__ unsigned f2bf(float f) { unsigned u = __builtin_bit_cast(unsigned, f); return (u + 0x7fffu + ((u >> 16) & 1u)) >> 16; }
__device__ __forceinline__ unsigned pk2(float lo, float hi) { return f2bf(lo) | (f2bf(hi) << 16); }
__device__ __forceinline__ float bf2f(unsigned short b) { return __builtin_bit_cast(float, (unsigned)b << 16); }
__device__ __forceinline__ float bflo(unsigned w) { return __builtin_bit_cast(float, w << 16); }
__device__ __forceinline__ float bfhi(unsigned w) { return __builtin_bit_cast(float, w & 0xffff0000u); }
__device__ __forceinline__ float wave_sum(float v) {
#pragma unroll
    for (int o = 1; o < 64; o <<= 1) v += __shfl_xor(v, o);
    return v;
}
__device__ __forceinline__ float sigmoidf_(float x) { return 1.f / (1.f + __expf(-x)); }
__device__ __forceinline__ float siluf_(float x) { return x / (1.f + __expf(-x)); }
__device__ __forceinline__ float gelu_tanh(float x) {
    const float u = 0.7978845608028654f * (x + 0.044715f * x * x * x);
    const float t = 1.f - 2.f / (1.f + __expf(2.f * u));
    return 0.5f * x * (1.f + t);
}
__device__ __forceinline__ f32x4 mma16(bf16x8 a, bf16x8 b, f32x4 c) { return __builtin_amdgcn_mfma_f32_16x16x32_bf16(a, b, c, 0, 0, 0); }
__device__ __forceinline__ bf16x8 pack8(f32x4 lo, f32x4 hi) {
    u32x4 w; w.x = pk2(lo.x, lo.y); w.y = pk2(lo.z, lo.w); w.z = pk2(hi.x, hi.y); w.w = pk2(hi.z, hi.w);
    return __builtin_bit_cast(bf16x8, w);
}

namespace pg8 {
constexpr int BM = 256, BK = 64, HALF = 128, HTB = HALF * BK * 2, STAGE_BYTES = 8 * HTB;
__device__ __forceinline__ int lds_byte(int r, int c) { const int st = (r >> 4) * 2 + (c >> 5), rr = r & 15, cc = c & 31, ob = rr * 64 + cc * 2; return st * 1024 + (ob ^ (((ob >> 9) & 1) << 5)); }
__device__ __forceinline__ void stage_rc(int b, int& R, int& C) { const int st = b / 1024, sb = b % 1024, swz = sb ^ (((sb >> 9) & 1) << 5); R = (st >> 1) * 16 + swz / 64; C = (st & 1) * 32 + (swz % 64) / 2; }
__device__ __forceinline__ int perm32(int rho) { const int n = rho >> 4, i = rho & 15; return 8 * (i >> 2) + 4 * n + (i & 3); }
__device__ __forceinline__ unsigned cvt_pk_bf16(float lo, float hi) { unsigned r; asm volatile("v_cvt_pk_bf16_f32 %0, %1, %2" : "=v"(r) : "v"(lo), "v"(hi)); return r; }

struct GUnit { const char* A; const char* B; int i0, i1, i2, i3; };

template <class Epi, class Sched>
__device__ __forceinline__ void gemm_phase(LAS unsigned char* lds, const int K, const int ldb, const Sched& S, const Epi& E) {
    const int tid = threadIdx.x, wid = __builtin_amdgcn_readfirstlane(tid >> 6), lane = tid & 63, wr = wid >> 2, wc = wid & 3, fr = lane & 15, fq = lane >> 4;
    const int nt = K / BK;
    int RA[2], CA[2]; unsigned voffB[2];
#pragma unroll
    for (int i = 0; i < 2; ++i) { int R, C; stage_rc(tid * 16 + i * 8192, R, C); const int Rb = Epi::PERM ? ((R & ~31) + perm32(R & 31)) : R;
        RA[i] = R; CA[i] = C; voffB[i] = (unsigned)(Rb * ldb + C) * 2u; }
    const size_t kstep = (size_t)(BK * 2);
    const size_t hstepB = (size_t)HALF * ldb * 2;
    const unsigned ldsw = (unsigned)wid * 1024u;
    const int aoff = lds_byte(wr * 64 + fr, fq * 8), boff = lds_byte(wc * 32 + fr, fq * 8);
#define PG8_SA(b, h) (((b) * 2 + (h)) * HTB)
#define PG8_SB(b, h) ((4 + (b) * 2 + (h)) * HTB)
#define PG8_STAGE(bufoff, gbase, voff) do { _Pragma("unroll") for (int _i = 0; _i < 2; ++_i) \
        __builtin_amdgcn_global_load_lds((const unsigned*)((const char*)(gbase) + (voff)[_i]), (LAS unsigned*)(lds + (bufoff) + ldsw + _i * 8192), 16, 0, 0); } while (0)
#define PG8_LDA(dst, b, h) do { _Pragma("unroll") for (int m = 0; m < 4; ++m) _Pragma("unroll") for (int k = 0; k < 2; ++k) dst[m][k] = *(const LAS bf16x8*)(lds + PG8_SA(b, h) + aoff + m * 2048 + k * 1024); } while (0)
#define PG8_LDB(dst, b, h) do { _Pragma("unroll") for (int n = 0; n < 2; ++n) _Pragma("unroll") for (int k = 0; k < 2; ++k) dst[n][k] = *(const LAS bf16x8*)(lds + PG8_SB(b, h) + boff + n * 2048 + k * 1024); } while (0)
#define PG8_MMA(ai, bj, At, Bt) do { __builtin_amdgcn_s_setprio(1); _Pragma("unroll") for (int m = 0; m < 4; ++m) _Pragma("unroll") for (int n = 0; n < 2; ++n) _Pragma("unroll") for (int k = 0; k < 2; ++k) \
        acc[ai][bj][m][n] = __builtin_amdgcn_mfma_f32_16x16x32_bf16(Bt[n][k], At[m][k], acc[ai][bj][m][n], 0, 0, 0); __builtin_amdgcn_s_setprio(0); } while (0)
#define PG8_WAIT_V(n) asm volatile("s_waitcnt vmcnt(" #n ")" ::: "memory")
#define PG8_WAIT_L(n) asm volatile("s_waitcnt lgkmcnt(" #n ")" ::: "memory")
#define PG8_BAR __builtin_amdgcn_s_barrier()
#define PG8_SCHED __builtin_amdgcn_sched_barrier(0)
    GUnit cur, nxt; int ui = 0;
    if (!S.next(0, cur)) return;
    unsigned vc[2][2], vn[2][2];
#pragma unroll
    for (int h = 0; h < 2; ++h)
#pragma unroll
        for (int i = 0; i < 2; ++i) vc[h][i] = S.arow(cur, h * HALF + RA[i]) + (unsigned)CA[i] * 2u;
    f32x4 acc[2][2][4][2];
#pragma unroll
    for (int a = 0; a < 2; ++a)
#pragma unroll
        for (int b = 0; b < 2; ++b)
#pragma unroll
            for (int m = 0; m < 4; ++m)
#pragma unroll
                for (int n = 0; n < 2; ++n) acc[a][b][m][n] = (f32x4){0.f, 0.f, 0.f, 0.f};
    bf16x8 At[4][2], B0[2][2], B1[2][2];
    const char* cA = cur.A; const char* cB = cur.B;
    PG8_STAGE(PG8_SB(0, 0), cB, voffB); PG8_STAGE(PG8_SB(0, 1), cB + hstepB, voffB); PG8_STAGE(PG8_SA(0, 0), cA, vc[0]); PG8_STAGE(PG8_SA(0, 1), cA, vc[1]);
    if (wr == 1) PG8_BAR;
    PG8_WAIT_V(2); PG8_BAR;
    PG8_STAGE(PG8_SB(1, 0), cB + kstep, voffB); PG8_STAGE(PG8_SA(1, 0), cA + kstep, vc[0]); PG8_STAGE(PG8_SB(1, 1), cB + hstepB + kstep, voffB);
    PG8_WAIT_V(6); PG8_BAR;
    for (;;) {
        const bool has_next = S.next(ui + 1, nxt);
        const char* nA = has_next ? nxt.A : cA; const char* nB = has_next ? nxt.B : cB;
#pragma unroll
        for (int h = 0; h < 2; ++h)
#pragma unroll
            for (int i = 0; i < 2; ++i) vn[h][i] = has_next ? (S.arow(nxt, h * HALF + RA[i]) + (unsigned)CA[i] * 2u) : vc[h][i];
#pragma unroll 1
        for (int t = 0; t < nt; t += 2) {
            const bool last = (t == nt - 2);
            const char* a1 = cA + (size_t)(t + 1) * kstep;
            const char* a2 = last ? nA : cA + (size_t)(t + 2) * kstep; const char* b2 = last ? nB : cB + (size_t)(t + 2) * kstep;
            const char* a3 = a2 + kstep; const char* b3 = b2 + kstep;
            unsigned va2[2][2];
#pragma unroll
            for (int h = 0; h < 2; ++h)
#pragma unroll
                for (int i = 0; i < 2; ++i) va2[h][i] = last ? vn[h][i] : vc[h][i];
            PG8_LDB(B0, 0, 0); PG8_LDB(B1, 0, 1); PG8_SCHED; PG8_LDA(At, 0, 0); PG8_STAGE(PG8_SA(1, 1), a1, vc[1]);
            PG8_WAIT_V(8); PG8_WAIT_L(0); PG8_BAR; PG8_MMA(0, 0, At, B0); PG8_MMA(0, 1, At, B1); PG8_BAR; PG8_SCHED;
            PG8_LDA(At, 0, 1); PG8_STAGE(PG8_SB(0, 0), b2, voffB); PG8_STAGE(PG8_SB(0, 1), b2 + hstepB, voffB); PG8_STAGE(PG8_SA(0, 0), a2, va2[0]);
            PG8_WAIT_V(8); PG8_WAIT_L(0); PG8_BAR; PG8_MMA(1, 0, At, B0); PG8_MMA(1, 1, At, B1); PG8_BAR; PG8_SCHED;
            PG8_LDB(B0, 1, 0); PG8_LDB(B1, 1, 1); PG8_SCHED; PG8_LDA(At, 1, 0); PG8_STAGE(PG8_SA(0, 1), a2, va2[1]);
            PG8_WAIT_V(8); PG8_WAIT_L(0); PG8_BAR; PG8_MMA(0, 0, At, B0); PG8_MMA(0, 1, At, B1); PG8_BAR; PG8_SCHED;
            PG8_LDA(At, 1, 1); PG8_STAGE(PG8_SB(1, 0), b3, voffB); PG8_STAGE(PG8_SB(1, 1), b3 + hstepB, voffB); PG8_STAGE(PG8_SA(1, 0), a3, va2[0]);
            PG8_WAIT_V(8); PG8_WAIT_L(0); PG8_BAR; PG8_MMA(1, 0, At, B0); PG8_MMA(1, 1, At, B1); PG8_BAR; PG8_SCHED;
        }
        if (wr == 0) PG8_BAR;
        E(acc, cur, wr, wc, fr, fq);
        if (!has_next) break;
#pragma unroll
        for (int a = 0; a < 2; ++a)
#pragma unroll
            for (int b = 0; b < 2; ++b)
#pragma unroll
                for (int m = 0; m < 4; ++m)
#pragma unroll
                    for (int n = 0; n < 2; ++n) acc[a][b][m][n] = (f32x4){0.f, 0.f, 0.f, 0.f};
        cur = nxt; cA = nA; cB = nB; ++ui;
#pragma unroll
        for (int h = 0; h < 2; ++h)
#pragma unroll
            for (int i = 0; i < 2; ++i) vc[h][i] = vn[h][i];
        if (wr == 1) PG8_BAR;
    }
    PG8_WAIT_V(0);
    PG8_BAR;
#undef PG8_SA
#undef PG8_SB
#undef PG8_STAGE
#undef PG8_LDA
#undef PG8_LDB
#undef PG8_MMA
#undef PG8_WAIT_V
#undef PG8_WAIT_L
#undef PG8_BAR
#undef PG8_SCHED
}

struct TileOrder {
    int nM, nN, nwg, G, c;
    __device__ void init(int nM_, int nN_, int G_, int c_) { nM = nM_; nN = nN_; nwg = nM * nN; G = G_; c = c_; }
    __device__ bool tile(int i, int& pm, int& pn) const {
        const long L = (long)i * G + c; if (c < 0 || L >= nwg) return false;
        int wgid = (int)L; { const int q = nwg / 8, r = nwg % 8, xcd = wgid % 8, off = wgid / 8; wgid = (xcd < r ? xcd * (q + 1) : r * (q + 1) + (xcd - r) * q) + off; }
        const int nig = 8 * nN, gid = wgid / nig, fm = gid * 8, gsz = (nM - fm) < 8 ? (nM - fm) : 8;
        pm = fm + ((wgid % nig) % gsz); pn = (wgid % nig) / gsz; return true;
    }
};
}
using pg8::GUnit;

#define XB_TMO      128
#define XB_XCNT(j)  (256  + 64 * (j))
#define XB_XSUB(j)  (1280 + 64 * (j))
#define XB_XGEN(j)  (2304 + 64 * (j))
#define XB_TOP      3328
#define XB_TOPGEN   3392
#define XCD_BAR_WORDS 3456
#define XB_SPIN_CAP (1u << 18)
__device__ __forceinline__ unsigned xb_ld(unsigned* p)              { return __hip_atomic_load(p, __ATOMIC_RELAXED, __HIP_MEMORY_SCOPE_AGENT); }
__device__ __forceinline__ unsigned xb_add(unsigned* p, unsigned v) { return __hip_atomic_fetch_add(p, v, __ATOMIC_RELAXED, __HIP_MEMORY_SCOPE_AGENT); }
__device__ __forceinline__ unsigned xb_xcc_id() { return (unsigned)__builtin_amdgcn_s_getreg((3 << 11) | 20) & 0xFu; }
#define XB_SPIN(cond, bar) do { unsigned _sp = 0; while (cond) { __builtin_amdgcn_s_sleep(1); \
    if ((++_sp & 255u) == 0u) { if (xb_ld(&(bar)[XB_TMO])) break; if (_sp > XB_SPIN_CAP) { atomicAdd(&(bar)[XB_TMO], 1u); break; } } } } while (0)
struct XcdBarrier { unsigned* bar; unsigned x; volatile LAS unsigned* st; };
__device__ __forceinline__ XcdBarrier xcd_barrier_post(unsigned* bar, volatile LAS unsigned* st) {
    XcdBarrier b; b.bar = bar; b.x = xb_xcc_id(); b.st = st;
    if (threadIdx.x == 0) (void)xb_add(&bar[XB_XCNT(b.x)], 1u);
    return b;
}
__device__ __forceinline__ void xcd_barrier_complete(unsigned* bar, unsigned x, unsigned& nloc, unsigned& nx) {
    const unsigned G = gridDim.x * gridDim.y * gridDim.z;
    unsigned sum, cnt, mine, sp = 0u;
    for (;;) {
        sum = 0u; cnt = 0u; mine = 0u;
#pragma unroll
        for (unsigned j = 0; j < 16; ++j) { const unsigned c = xb_ld(&bar[XB_XCNT(j)]); sum += c; cnt += (c > 0u) ? 1u : 0u; mine = (j == x) ? c : mine; }
        if (sum == G) break;
        __builtin_amdgcn_s_sleep(1);
        if ((++sp & 255u) == 0u) { if (xb_ld(&bar[XB_TMO])) break; if (sp > XB_SPIN_CAP) { atomicAdd(&bar[XB_TMO], 1u); break; } }
    }
    nloc = mine > 0u ? mine : 1u; nx = cnt > 0u ? cnt : 1u;
}
__device__ __forceinline__ void xcd_barrier(const XcdBarrier& b) {
    asm volatile("s_waitcnt vmcnt(0)" ::: "memory");
    __syncthreads();
    if (threadIdx.x == 0) {
        unsigned* bar = b.bar;
        __builtin_amdgcn_s_waitcnt(0);
        unsigned nloc = b.st[0], nx = b.st[1];
        if (nloc == 0u) { xcd_barrier_complete(bar, b.x, nloc, nx); b.st[0] = nloc; b.st[1] = nx; }
        const unsigned old = xb_add(&bar[XB_XSUB(b.x)], 1u);
        const unsigned gen = old / nloc;
        if (old + 1u == (gen + 1u) * nloc) {
            __builtin_amdgcn_fence(__ATOMIC_RELEASE, "agent");
            asm volatile("s_waitcnt vmcnt(0)" ::: "memory");
            const unsigned og = xb_add(&bar[XB_TOP], 1u);
            const unsigned tg = og / nx;
            if (og + 1u == (tg + 1u) * nx) xb_add(&bar[XB_TOPGEN], 1u);
            else XB_SPIN(xb_ld(&bar[XB_TOPGEN]) == tg, bar);
            __builtin_amdgcn_fence(__ATOMIC_ACQUIRE, "agent");
            xb_add(&bar[XB_XGEN(b.x)], 1u);
            asm volatile("s_waitcnt vmcnt(0)" ::: "memory");
        } else {
            XB_SPIN(xb_ld(&bar[XB_XGEN(b.x)]) == gen, bar);
            __builtin_amdgcn_fence(__ATOMIC_ACQUIRE, "agent");
            asm volatile("s_waitcnt vmcnt(0)" ::: "memory");
        }
    }
    __syncthreads();
}

struct Args { const float* in[28]; float* out; unsigned char* ws; int ph_lo, ph_hi; };
enum { I_X = 0, I_C, I_N1G, I_N2G, I_WADA, I_BADA, I_WIN, I_LRE, I_LIM, I_LSTEP, I_BRE, I_BIM, I_CRE, I_CIM, I_S5D, I_WGLU, I_BGLU, I_CONVW, I_ALOG, I_DTB, I_GNG, I_WOUT, I_WRG, I_WRE, I_WG, I_WU, I_WDN, I_NFG };

struct Frame {
    LAS unsigned char* lds;
    volatile LAS unsigned* MISC;
    int tid, lane, wave, vcu, G;
    const float* in[28]; float* out;
    unsigned char* ws;
};
#define WSP(T, off) ((T*)(F.ws + (off)))

__device__ __forceinline__ void p0_transpose_item(const float* W, int ldw, int K, bf16* WT, int dst_row0, int k0, int n0, LAS float* scr, int lane) {
#pragma unroll 8
    for (int i = 0; i < 32; ++i) { const int kk = 2 * i + (lane >> 5); scr[kk * 33 + (lane & 31)] = W[(size_t)(k0 + kk) * ldw + n0 + (lane & 31)]; }
    LDS_WAIT(); asm volatile("" ::: "memory");
    const int c = lane & 7;
#pragma unroll
    for (int j = 0; j < 4; ++j) { const int n = (lane >> 3) + 8 * j; const LAS float* s = scr + (8 * c) * 33 + n;
        u32x4 o; o.x = pk2(s[0 * 33], s[1 * 33]); o.y = pk2(s[2 * 33], s[3 * 33]); o.z = pk2(s[4 * 33], s[5 * 33]); o.w = pk2(s[6 * 33], s[7 * 33]);
        *(u32x4*)(WT + (size_t)(dst_row0 + n) * K + k0 + 8 * c) = o; }
    LDS_WAIT(); asm volatile("" ::: "memory");
}

__device__ __forceinline__ void p0_mod_gemv(Frame& F) {
    const float* c = F.in[I_C]; const float* wada = F.in[I_WADA]; const float* bada = F.in[I_BADA];
    LAS float* cact = (LAS float*)F.lds;
    LAS float* red = (LAS float*)(F.lds + 16384);
    for (int i = F.tid; i < 4096; i += 512) cact[i] = siluf_(c[i]);
    __syncthreads();
    const int col = F.vcu * 64 + F.lane;
    float acc[4] = {0.f, 0.f, 0.f, 0.f};
    const int kb = F.wave * 128;
#pragma unroll 8
    for (int k = 0; k < 128; ++k) { const float w = wada[(size_t)(kb + k) * 6144 + col];
#pragma unroll
        for (int b = 0; b < 4; ++b) acc[b] += cact[b * 1024 + kb + k] * w; }
#pragma unroll
    for (int b = 0; b < 4; ++b) red[(F.wave * 4 + b) * 64 + F.lane] = acc[b];
    __syncthreads();
    if (F.wave == 0) {
        float* mod = WSP(float, WS_MOD);
#pragma unroll
        for (int b = 0; b < 4; ++b) { float s = bada[col];
#pragma unroll
            for (int w = 0; w < 8; ++w) s += red[(w * 4 + b) * 64 + F.lane];
            mod[b * 6144 + col] = s; }
    }
    __syncthreads();
}

__device__ __forceinline__ void p0_s5_matrices(Frame& F, int g) {
    const float* lre = F.in[I_LRE] + g * SP; const float* lim = F.in[I_LIM] + g * SP;
    const float* bre = F.in[I_BRE] + (size_t)g * SP * 16; const float* bim = F.in[I_BIM] + (size_t)g * SP * 16;
    const float* cre = F.in[I_CRE] + (size_t)g * 16 * SP; const float* cim = F.in[I_CIM] + (size_t)g * 16 * SP;
    LAS float* lbr = (LAS float*)F.lds;
    LAS float* lbi = lbr + 17 * 64;
    LAS float* bbr = lbi + 17 * 64;
    LAS float* bbi = bbr + 1024;
    LAS float* cr = bbi + 1024;
    LAS float* ci = cr + 1024;
    LAS float* Kt = ci + 1024;
    const double step = exp((double)F.in[I_LSTEP][g]);
    for (int idx = F.tid; idx < 17 * 64; idx += 512) { const int n = idx >> 6, p = idx & 63;
        const double a = (double)lre[p] * step * n, th = (double)lim[p] * step * n; const double m = exp(a);
        lbr[idx] = (float)(m * cos(th)); lbi[idx] = (float)(m * sin(th)); }
    for (int idx = F.tid; idx < 1024; idx += 512) { const int p = idx >> 4;
        const double lr = lre[p], li = lim[p]; const double a = lr * step, th = li * step, m = exp(a);
        const double nr = m * cos(th) - 1.0, ni = m * sin(th), den = lr * lr + li * li;
        const double qr = (nr * lr + ni * li) / den, qi = (ni * lr - nr * li) / den;
        const double br = bre[idx], bi = bim[idx];
        bbr[idx] = (float)(qr * br - qi * bi); bbi[idx] = (float)(qr * bi + qi * br);
        cr[idx] = cre[idx]; ci[idx] = cim[idx]; }
    __syncthreads();
    for (int idx = F.tid; idx < 4096; idx += 512) { const int n = idx >> 8, h = (idx >> 4) & 15, hp = idx & 15; float s = 0.f;
        for (int p = 0; p < 64; ++p) { const float tr = cr[h * 64 + p] * lbr[n * 64 + p] - ci[h * 64 + p] * lbi[n * 64 + p], ti = cr[h * 64 + p] * lbi[n * 64 + p] + ci[h * 64 + p] * lbr[n * 64 + p];
            s += tr * bbr[p * 16 + hp] - ti * bbi[p * 16 + hp]; }
        Kt[idx] = s; }
    __syncthreads();
    bf16* bty = WSP(bf16, WS_BTY) + (size_t)g * 256 * KY;
    for (int idx = F.tid; idx < 256 * KY; idx += 512) { const int nn = idx / KY, k = idx - nn * KY, t = nn >> 4, h = nn & 15; float v;
        if (k < 256) { const int s = k >> 4, hp = k & 15; v = (t >= s) ? Kt[((t - s) * 16 + h) * 16 + hp] : 0.f; }
        else { const int kk = k - 256, ri = kk >> 6, p = kk & 63; const float a = cr[h * 64 + p], b = ci[h * 64 + p], lr = lbr[(t + 1) * 64 + p], li = lbi[(t + 1) * 64 + p];
            v = ri == 0 ? (a * lr - b * li) : -(a * li + b * lr); }
        bty[idx] = (bf16)f2bf(v); }
    bf16* wzt = WSP(bf16, WS_WZT) + (size_t)g * 128 * 256;
    for (int idx = F.tid; idx < 128 * 256; idx += 512) { const int nz = idx >> 8, k = idx & 255, ri = nz >> 6, p = nz & 63, s = k >> 4, hp = k & 15;
        const float lr = lbr[(15 - s) * 64 + p], li = lbi[(15 - s) * 64 + p], br = bbr[p * 16 + hp], bi = bbi[p * 16 + hp];
        wzt[idx] = (bf16)f2bf(ri == 0 ? (lr * br - li * bi) : (lr * bi + li * br)); }
    if (F.tid < 64) { float* l16 = WSP(float, WS_LAM16) + (g * 64 + F.tid) * 2; l16[0] = lbr[16 * 64 + F.tid]; l16[1] = lbi[16 * 64 + F.tid]; }
    __syncthreads();
}

__device__ __forceinline__ void p0_prologue(Frame& F) {
    if (F.vcu < 96) p0_mod_gemv(F);
    else if (F.vcu < 128) p0_s5_matrices(F, F.vcu - 96);
    LAS float* scr = (LAS float*)(F.lds + F.wave * 16384);
    const int gw = F.vcu * 8 + F.wave, NGW = F.G * 8;
    constexpr int I_IN = 16 * 80, I_GLU = 8 * 16, I_OUT = 16 * 32, I_E = 128, I_SMALL = I_IN + I_GLU + I_OUT, NITEMS = I_SMALL + NE * 3 * I_E;
    for (int it = gw; it < NITEMS; it += NGW) {
        int r = it;
        if (r < I_IN) { const int kb = r / 80, nb = r % 80; p0_transpose_item(F.in[I_WIN], D_IN, D, WSP(bf16, WS_WIN), nb * 32, kb * 64, nb * 32, scr, F.lane); continue; } r -= I_IN;
        if (r < I_GLU) { const int kb = r / 16, nb = r % 16; p0_transpose_item(F.in[I_WGLU], 512, 512, WSP(bf16, WS_WGLU), nb * 32, kb * 64, nb * 32, scr, F.lane); continue; } r -= I_GLU;
        if (r < I_OUT) { const int kb = r / 32, nb = r % 32; p0_transpose_item(F.in[I_WOUT], D, D, WSP(bf16, WS_WOUT), nb * 32, kb * 64, nb * 32, scr, F.lane); continue; } r -= I_OUT;
        const int e = r / (3 * I_E), q = r % (3 * I_E), which = q / I_E, j = q % I_E;
        if (which < 2) { const int kb = j / 8, nb = j % 8, n0 = nb * 32;
            p0_transpose_item((which == 0 ? F.in[I_WG] : F.in[I_WU]) + (size_t)e * D * DE, DE, D, WSP(bf16, WS_WGU) + (size_t)e * 512 * D, 256 * (n0 >> 7) + 128 * which + (n0 & 127), kb * 64, n0, scr, F.lane); }
        else { const int kb = j / 32, nb = j % 32;
            p0_transpose_item(F.in[I_WDN] + (size_t)e * DE * D, D, DE, WSP(bf16, WS_WD) + (size_t)e * D * DE, nb * 32, kb * 64, nb * 32, scr, F.lane); }
    }
}

__device__ __forceinline__ void p1_ain(Frame& F) {
    const float* x = F.in[I_X]; const float* g1 = F.in[I_N1G]; const float* win = F.in[I_WIN];
    const float* mod = WSP(float, WS_MOD);
    LAS float* wg = (LAS float*)F.lds;
    for (int i = F.tid; i < 8192; i += 512) { const int k = i >> 3, j = i & 7; wg[j * 1024 + k] = win[(size_t)k * D_IN + N_IN + j]; }
    __syncthreads();
    bf16* ain = WSP(bf16, WS_AIN); float* gg = WSP(float, WS_GG); float* bt = WSP(float, WS_BETA);
    const float* alog = F.in[I_ALOG]; const float* dtb = F.in[I_DTB];
    const int gw = F.vcu * 8 + F.wave, NGW = F.G * 8;
    for (int m = gw; m < M; m += NGW) {
        const int b = m >> 12;
        const f32x4* xr = (const f32x4*)(x + (size_t)m * D) + F.lane;
        f32x4 v[4]; float ss = 0.f;
#pragma unroll
        for (int j = 0; j < 4; ++j) { v[j] = xr[64 * j]; ss += (v[j].x * v[j].x + v[j].y * v[j].y) + (v[j].z * v[j].z + v[j].w * v[j].w); }
        const float rstd = 1.f / sqrtf(wave_sum(ss) * (1.f / D) + EPS);
        float ga[8];
#pragma unroll
        for (int q = 0; q < 8; ++q) ga[q] = 0.f;
        u32x2* o8 = (u32x2*)(ain + (size_t)m * D) + F.lane;
#pragma unroll
        for (int j = 0; j < 4; ++j) { const int k = 4 * F.lane + 256 * j;
            const f32x4 gv = *(const f32x4*)(g1 + k), sh = *(const f32x4*)(mod + b * 6144 + k), sc = *(const f32x4*)(mod + b * 6144 + 1024 + k);
            f32x4 a = v[j] * rstd * gv * (sc + 1.f) + sh;
            u32x2 w; w.x = pk2(a.x, a.y); w.y = pk2(a.z, a.w); o8[64 * j] = w;
#pragma unroll
            for (int q = 0; q < 8; ++q) { const f32x4 wv = *(const LAS f32x4*)(wg + q * 1024 + k); ga[q] += (a.x * wv.x + a.y * wv.y) + (a.z * wv.z + a.w * wv.w); } }
#pragma unroll
        for (int q = 0; q < 8; ++q) ga[q] = wave_sum(ga[q]);
        if (F.lane < 4) { const int h = F.lane; const float av = (h == 0 ? ga[0] : h == 1 ? ga[1] : h == 2 ? ga[2] : ga[3]) + dtb[h], bv = (h == 0 ? ga[4] : h == 1 ? ga[5] : h == 2 ? ga[6] : ga[7]);
            const float sp = fmaxf(av, 0.f) + log1pf(expf(-fabsf(av)));
            gg[(size_t)m * 4 + h] = -expf(alog[h]) * sp; bt[(size_t)m * 4 + h] = 1.f / (1.f + expf(-bv)); }
    }
}

struct SchedDense {
    pg8::TileOrder T; const char* A; const char* B; int lda, ldb;
    __device__ __forceinline__ bool next(int i, GUnit& u) const { int pm, pn; if (!T.tile(i, pm, pn)) return false;
        u.A = A + (size_t)pm * 256 * lda * 2; u.B = B + (size_t)pn * 256 * ldb * 2; u.i0 = pm; u.i1 = pn; u.i2 = 0; u.i3 = 0; return true; }
    __device__ __forceinline__ unsigned arow(const GUnit&, int r) const { return (unsigned)(r * lda) * 2u; }
};
struct EpiInProj {
    static constexpr bool PERM = true;
    bf16* ay; bf16* qkv; bf16* z;
    __device__ __forceinline__ void operator()(const f32x4 (&acc)[2][2][4][2], const GUnit& u, int wr, int wc, int fr, int fq) const {
        const int pm = u.i0, pn = u.i1;
#pragma unroll
        for (int ai = 0; ai < 2; ++ai)
#pragma unroll
            for (int m = 0; m < 4; ++m) { const int row = pm * 256 + ai * 128 + wr * 64 + m * 16 + fr;
#pragma unroll
                for (int bj = 0; bj < 2; ++bj) { const int col = pn * 256 + bj * 128 + wc * 32 + 8 * fq;
                    const f32x4 v0 = acc[ai][bj][m][0], v1 = acc[ai][bj][m][1];
                    u32x4 w; w.x = pg8::cvt_pk_bf16(v0[0], v0[1]); w.y = pg8::cvt_pk_bf16(v0[2], v0[3]); w.z = pg8::cvt_pk_bf16(v1[0], v1[1]); w.w = pg8::cvt_pk_bf16(v1[2], v1[3]);
                    bf16* dst;
                    if (pn < 2) { const int g = col >> 4, hp = col & 15, b = row >> 12, tl = row & 4095; dst = ay + ((size_t)g * 1024 + b * 256 + (tl >> 4)) * KY + (tl & 15) * 16 + hp; }
                    else if (pn < 8) dst = qkv + (size_t)row * 1536 + (col - 512);
                    else dst = z + (size_t)row * 512 + (col - 2048);
                    *(u32x4*)dst = w; } }
    }
};
struct SchedS5Y {
    int G, c; const char* ay; const char* bty;
    __device__ __forceinline__ bool next(int i, GUnit& u) const { const int L = i * G + c; if (c < 0 || L >= 128) return false; const int g = L >> 2, pm = L & 3;
        u.A = ay + ((size_t)g * 1024 + pm * 256) * KY * 2; u.B = bty + (size_t)g * 256 * KY * 2; u.i0 = pm; u.i1 = g; u.i2 = 0; u.i3 = 0; return true; }
    __device__ __forceinline__ unsigned arow(const GUnit&, int r) const { return (unsigned)(r * KY) * 2u; }
};
struct EpiS5Y {
    static constexpr bool PERM = true;
    const float* s5d; bf16* yg;
    __device__ __forceinline__ void operator()(const f32x4 (&acc)[2][2][4][2], const GUnit& u, int wr, int wc, int fr, int fq) const {
        const int pm = u.i0, g = u.i1;
#pragma unroll
        for (int ai = 0; ai < 2; ++ai)
#pragma unroll
            for (int m = 0; m < 4; ++m) { const int R = pm * 256 + ai * 128 + wr * 64 + m * 16 + fr;
#pragma unroll
                for (int bj = 0; bj < 2; ++bj) { const int n = bj * 128 + wc * 32 + 8 * fq, t = n >> 4, h0 = n & 15;
                    const int token = (R >> 8) * SEQ + (R & 255) * CS + t, ch = g * 16 + h0;
                    const u32x4 uu = *(const u32x4*)(u.A + ((size_t)(ai * 128 + wr * 64 + m * 16 + fr) * KY + n) * 2);
                    const f32x4 d0 = *(const f32x4*)(s5d + ch), d1 = *(const f32x4*)(s5d + ch + 4);
                    const f32x4 v0 = acc[ai][bj][m][0], v1 = acc[ai][bj][m][1];
                    float y[8];
                    y[0] = v0[0] + d0[0] * bflo(uu.x); y[1] = v0[1] + d0[1] * bfhi(uu.x); y[2] = v0[2] + d0[2] * bflo(uu.y); y[3] = v0[3] + d0[3] * bfhi(uu.y);
                    y[4] = v1[0] + d1[0] * bflo(uu.z); y[5] = v1[1] + d1[1] * bfhi(uu.z); y[6] = v1[2] + d1[2] * bflo(uu.w); y[7] = v1[3] + d1[3] * bfhi(uu.w);
#pragma unroll
                    for (int q = 0; q < 8; ++q) y[q] = gelu_tanh(y[q]);
                    u32x4 w; w.x = pg8::cvt_pk_bf16(y[0], y[1]); w.y = pg8::cvt_pk_bf16(y[2], y[3]); w.z = pg8::cvt_pk_bf16(y[4], y[5]); w.w = pg8::cvt_pk_bf16(y[6], y[7]);
                    *(u32x4*)(yg + (size_t)token * 512 + ch) = w; } }
    }
};
struct EpiGlu {
    static constexpr bool PERM = true;
    const bf16* yg; const float* bglu; bf16* cc;
    __device__ __forceinline__ void operator()(const f32x4 (&acc)[2][2][4][2], const GUnit& u, int wr, int wc, int fr, int fq) const {
        const int pm = u.i0, pn = u.i1;
#pragma unroll
        for (int ai = 0; ai < 2; ++ai)
#pragma unroll
            for (int m = 0; m < 4; ++m) { const int row = pm * 256 + ai * 128 + wr * 64 + m * 16 + fr;
#pragma unroll
                for (int bj = 0; bj < 2; ++bj) { const int col = pn * 256 + bj * 128 + wc * 32 + 8 * fq;
                    const u32x4 uu = *(const u32x4*)(yg + (size_t)row * 512 + col);
                    const f32x4 b0 = *(const f32x4*)(bglu + col), b1 = *(const f32x4*)(bglu + col + 4);
                    const f32x4 v0 = acc[ai][bj][m][0] + b0, v1 = acc[ai][bj][m][1] + b1;
                    float y[8];
                    y[0] = bflo(uu.x) * sigmoidf_(v0[0]); y[1] = bfhi(uu.x) * sigmoidf_(v0[1]); y[2] = bflo(uu.y) * sigmoidf_(v0[2]); y[3] = bfhi(uu.y) * sigmoidf_(v0[3]);
                    y[4] = bflo(uu.z) * sigmoidf_(v1[0]); y[5] = bfhi(uu.z) * sigmoidf_(v1[1]); y[6] = bflo(uu.w) * sigmoidf_(v1[2]); y[7] = bfhi(uu.w) * sigmoidf_(v1[3]);
                    u32x4 w; w.x = pg8::cvt_pk_bf16(y[0], y[1]); w.y = pg8::cvt_pk_bf16(y[2], y[3]); w.z = pg8::cvt_pk_bf16(y[4], y[5]); w.w = pg8::cvt_pk_bf16(y[6], y[7]);
                    *(u32x4*)(cc + (size_t)row * D + col) = w; } }
    }
};
struct EpiOutProj {
    static constexpr bool PERM = false;
    const float* x; const float* mod; float* h;
    __device__ __forceinline__ void operator()(const f32x4 (&acc)[2][2][4][2], const GUnit& u, int wr, int wc, int fr, int fq) const {
        const int pm = u.i0, pn = u.i1;
#pragma unroll
        for (int ai = 0; ai < 2; ++ai)
#pragma unroll
            for (int m = 0; m < 4; ++m) { const int row = pm * 256 + ai * 128 + wr * 64 + m * 16 + fr, b = row >> 12;
#pragma unroll
                for (int bj = 0; bj < 2; ++bj)
#pragma unroll
                    for (int n = 0; n < 2; ++n) { const int col = pn * 256 + bj * 128 + wc * 32 + 16 * n + 4 * fq;
                        const f32x4 xv = *(const f32x4*)(x + (size_t)row * D + col), gt = *(const f32x4*)(mod + b * 6144 + 2048 + col);
                        *(f32x4*)(h + (size_t)row * D + col) = xv + gt * acc[ai][bj][m][n]; } }
    }
};
template <int GATHER, int NCOL, int LDA>
struct SchedMoe {
    volatile LAS unsigned* tb; int G, c; unsigned char* ws;
    __device__ __forceinline__ bool next(int i, GUnit& u) const {
        const int L = i * G + c, NT = (int)tb[32]; if (L >= NT * NCOL) return false;
        const int tau = L / NCOL, pn = L - tau * NCOL; int e = 0;
        for (int q = 1; q < 32; ++q) e += ((int)tb[q] <= tau) ? 1 : 0;
        const int rt = tau - (int)tb[e];
        u.i0 = tau; u.i1 = pn; u.i2 = e; u.i3 = rt;
        if (GATHER) { u.A = (const char*)(ws + WS_AIN); u.B = (const char*)(ws + WS_WGU) + (size_t)e * (512 * D * 2) + (size_t)pn * 256 * LDA * 2; }
        else { u.A = (const char*)(ws + WS_ACT) + (size_t)tau * 256 * LDA * 2; u.B = (const char*)(ws + WS_WD) + (size_t)e * (D * DE * 2) + (size_t)pn * 256 * LDA * 2; }
        return true; }
    __device__ __forceinline__ unsigned arow(const GUnit& u, int r) const {
        if (!GATHER) return (unsigned)(r * LDA) * 2u;
        const int e = u.i2, sl = u.i3 * 256 + r; const unsigned n = ((const unsigned*)(ws + WS_CTL))[CW_CNT + 64 * e];
        const unsigned tok = (unsigned)sl < n ? (((const unsigned*)(ws + WS_LTOK))[(size_t)e * CAP + sl] & 0x7fffffffu) : 0u;
        return tok * (unsigned)(LDA * 2); }
};
struct EpiGateUp {
    static constexpr bool PERM = true;
    bf16* act;
    __device__ __forceinline__ void operator()(const f32x4 (&acc)[2][2][4][2], const GUnit& u, int wr, int wc, int fr, int fq) const {
        const int tau = u.i0, pn = u.i1;
#pragma unroll
        for (int ai = 0; ai < 2; ++ai)
#pragma unroll
            for (int m = 0; m < 4; ++m) { const int row = tau * 256 + ai * 128 + wr * 64 + m * 16 + fr, col = pn * 128 + wc * 32 + 8 * fq;
                const f32x4 g0 = acc[ai][0][m][0], g1 = acc[ai][0][m][1], u0 = acc[ai][1][m][0], u1 = acc[ai][1][m][1];
                u32x4 w; w.x = pg8::cvt_pk_bf16(siluf_(g0[0]) * u0[0], siluf_(g0[1]) * u0[1]); w.y = pg8::cvt_pk_bf16(siluf_(g0[2]) * u0[2], siluf_(g0[3]) * u0[3]);
                w.z = pg8::cvt_pk_bf16(siluf_(g1[0]) * u1[0], siluf_(g1[1]) * u1[1]); w.w = pg8::cvt_pk_bf16(siluf_(g1[2]) * u1[2], siluf_(g1[3]) * u1[3]);
                *(u32x4*)(act + (size_t)row * DE + col) = w; }
    }
};
struct EpiDown {
    static constexpr bool PERM = true;
    unsigned char* ws;
    __device__ __forceinline__ void operator()(const f32x4 (&acc)[2][2][4][2], const GUnit& u, int wr, int wc, int fr, int fq) const {
        const int pn = u.i1, e = u.i2, rt = u.i3; const unsigned n = ((const unsigned*)(ws + WS_CTL))[CW_CNT + 64 * e];
        const unsigned cbase = (unsigned)(pn * 256 + wc * 32 + 8 * fq);
        const int sl0 = rt * 256 + wr * 64 + fr;
        const unsigned* lt = (const unsigned*)(ws + WS_LTOK) + (size_t)e * CAP + sl0; const float* lwp = (const float*)(ws + WS_LW) + (size_t)e * CAP + sl0;
        bf16* ys = (bf16*)(ws + WS_YSLOT);
#pragma unroll
        for (int ai = 0; ai < 2; ++ai)
#pragma unroll
            for (int m = 0; m < 4; ++m) { const int o = ai * 128 + m * 16;
                const bool ok = (unsigned)(sl0 + o) < n; const int oo = ok ? o : -sl0;
                const unsigned tk = lt[oo]; const float wgt = lwp[oo];
                const unsigned off = ok ? ((tk >> 31) * (unsigned)M + (tk & 0x7fffffffu)) * (unsigned)D + cbase : (unsigned)((WS_DUMP - WS_YSLOT) / 2) + cbase;
#pragma unroll
                for (int bj = 0; bj < 2; ++bj) { const f32x4 v0 = acc[ai][bj][m][0] * wgt, v1 = acc[ai][bj][m][1] * wgt;
                    u32x4 w; w.x = pg8::cvt_pk_bf16(v0[0], v0[1]); w.y = pg8::cvt_pk_bf16(v0[2], v0[3]); w.z = pg8::cvt_pk_bf16(v1[0], v1[1]); w.w = pg8::cvt_pk_bf16(v1[2], v1[3]);
                    *(u32x4*)(ys + off + bj * 128) = w; }
                asm volatile("" ::: "memory"); }
    }
};

__device__ __forceinline__ void s5_state_unit(Frame& F, int unit) {
    const int b = unit >> 5, g = unit & 31, lane = F.lane, li = lane & 15, lq = lane >> 4;
    bf16* ay = WSP(bf16, WS_AY) + ((size_t)g * 1024 + b * 256) * KY;
    const bf16* wzt = WSP(bf16, WS_WZT) + (size_t)g * 128 * 256;
    LAS float* zb = (LAS float*)F.lds;
    f32x4 acc[2][8];
#pragma unroll
    for (int r = 0; r < 2; ++r)
#pragma unroll
        for (int c = 0; c < 8; ++c) acc[r][c] = (f32x4){0.f, 0.f, 0.f, 0.f};
    for (int ks = 0; ks < 8; ++ks) {
        bf16x8 af[2], bfr[8];
#pragma unroll
        for (int r = 0; r < 2; ++r) af[r] = *(const bf16x8*)(ay + (size_t)((2 * F.wave + r) * 16 + li) * KY + ks * 32 + lq * 8);
#pragma unroll
        for (int c = 0; c < 8; ++c) bfr[c] = *(const bf16x8*)(wzt + (size_t)(c * 16 + li) * 256 + ks * 32 + lq * 8);
#pragma unroll
        for (int r = 0; r < 2; ++r)
#pragma unroll
            for (int c = 0; c < 8; ++c) acc[r][c] = mma16(af[r], bfr[c], acc[r][c]);
    }
#pragma unroll
    for (int r = 0; r < 2; ++r)
#pragma unroll
        for (int c = 0; c < 8; ++c)
#pragma unroll
            for (int q = 0; q < 4; ++q) zb[((2 * F.wave + r) * 16 + lq * 4 + q) * 129 + c * 16 + li] = acc[r][c][q];
    __syncthreads();
    if (F.wave == 0) {
        const float* l16 = WSP(float, WS_LAM16) + (g * 64 + lane) * 2; const float Lr = l16[0], Li = l16[1];
        float sr = 0.f, si = 0.f;
        for (int c = 0; c < NCH; ++c) {
            ay[(size_t)c * KY + 256 + lane] = (bf16)f2bf(sr); ay[(size_t)c * KY + 320 + lane] = (bf16)f2bf(si);
            const float zr = zb[c * 129 + lane], zi = zb[c * 129 + 64 + lane];
            const float nr = Lr * sr - Li * si + zr, ni = Lr * si + Li * sr + zi; sr = nr; si = ni;
        }
    }
    __syncthreads();
}

constexpr int PQ = 0, PK = 17408, PKB = 34816, PVB = 53248, PKT = 71680, PL = 90112, PT = 107520, PG = 116736, PB = 116992;
__device__ __forceinline__ void gdn_prep_unit(Frame& F, int unit) {
    const int bh = unit >> 6, n = unit & 63, b = bh >> 2, h = bh & 3, tid = F.tid, lane = F.lane, wave = F.wave, li = lane & 15, lq = lane >> 4;
    const int tok0 = b * SEQ + n * GC;
    const bf16* qkv = WSP(bf16, WS_QKV); const float* convw = F.in[I_CONVW];
    LAS bf16* Qs = (LAS bf16*)(F.lds + PQ); LAS bf16* Ks = (LAS bf16*)(F.lds + PK); LAS bf16* KbT = (LAS bf16*)(F.lds + PKB); LAS bf16* VbT = (LAS bf16*)(F.lds + PVB);
    LAS bf16* KtT = (LAS bf16*)(F.lds + PKT); LAS float* Lm = (LAS float*)(F.lds + PL); LAS bf16* Tm = (LAS bf16*)(F.lds + PT); LAS float* Gs = (LAS float*)(F.lds + PG); LAS float* Bs = (LAS float*)(F.lds + PB);
    unsigned char* cha = F.ws + WS_CHA + (size_t)unit * CHA_BYTES;
    if (wave == 0) { float gv = WSP(float, WS_GG)[(size_t)(tok0 + lane) * 4 + h]; const float bv = WSP(float, WS_BETA)[(size_t)(tok0 + lane) * 4 + h];
#pragma unroll
        for (int d = 1; d < 64; d <<= 1) { const float o = __shfl_up(gv, d); if (lane >= d) gv += o; }
        Gs[lane] = gv; Bs[lane] = bv; if (lane == 63) WSP(float, WS_GL)[unit] = __expf(gv); }
    __syncthreads();
    { const int r = tid >> 3, seg = tid & 7, tl = n * GC + r;
      const float Gr = Gs[r], G63 = Gs[63], br = Bs[r], eg = __expf(Gr);
#pragma unroll
      for (int mat = 0; mat < 3; ++mat) {
          const int colq = mat * 512 + h * 128 + seg * 16;
          float a[16];
#pragma unroll
          for (int c = 0; c < 16; ++c) a[c] = 0.f;
#pragma unroll
          for (int j = 0; j < 4; ++j) { if (tl - 3 + j >= 0) { const bf16* xp = qkv + (size_t)(tok0 + r - 3 + j) * 1536 + colq; const u32x4 x0 = *(const u32x4*)xp, x1 = *(const u32x4*)(xp + 8);
                  const float* wp = convw + j * 1536 + colq; const f32x4 w0 = *(const f32x4*)wp, w1 = *(const f32x4*)(wp + 4), w2 = *(const f32x4*)(wp + 8), w3 = *(const f32x4*)(wp + 12);
                  a[0] += w0[0] * bflo(x0.x); a[1] += w0[1] * bfhi(x0.x); a[2] += w0[2] * bflo(x0.y); a[3] += w0[3] * bfhi(x0.y);
                  a[4] += w1[0] * bflo(x0.z); a[5] += w1[1] * bfhi(x0.z); a[6] += w1[2] * bflo(x0.w); a[7] += w1[3] * bfhi(x0.w);
                  a[8] += w2[0] * bflo(x1.x); a[9] += w2[1] * bfhi(x1.x); a[10] += w2[2] * bflo(x1.y); a[11] += w2[3] * bfhi(x1.y);
                  a[12] += w3[0] * bflo(x1.z); a[13] += w3[1] * bfhi(x1.z); a[14] += w3[2] * bflo(x1.w); a[15] += w3[3] * bfhi(x1.w); } }
          float ss = 0.f;
#pragma unroll
          for (int c = 0; c < 16; ++c) { a[c] = siluf_(a[c]); ss += a[c] * a[c]; }
          if (mat < 2) { ss += __shfl_xor(ss, 1); ss += __shfl_xor(ss, 2); ss += __shfl_xor(ss, 4);
              const float rn = (1.f / sqrtf(ss + EPS)) * (mat == 0 ? 0.08838834764831845f : 1.f);
#pragma unroll
              for (int c = 0; c < 16; ++c) a[c] *= rn; }
          if (mat == 0) {
              u32x4 w0, w1; w0.x = pk2(a[0], a[1]); w0.y = pk2(a[2], a[3]); w0.z = pk2(a[4], a[5]); w0.w = pk2(a[6], a[7]); w1.x = pk2(a[8], a[9]); w1.y = pk2(a[10], a[11]); w1.z = pk2(a[12], a[13]); w1.w = pk2(a[14], a[15]);
              *(LAS u32x4*)(Qs + r * 136 + seg * 16) = w0; *(LAS u32x4*)(Qs + r * 136 + seg * 16 + 8) = w1;
              bf16* qd = (bf16*)(cha + 16384);
#pragma unroll
              for (int gc = 0; gc < 4; ++gc) { u32x2 w; w.x = pk2(a[4 * gc] * eg, a[4 * gc + 1] * eg); w.y = pk2(a[4 * gc + 2] * eg, a[4 * gc + 3] * eg);
                  *(u32x2*)(qd + ((size_t)(((r >> 4) * 4 + (seg >> 1)) * 64 + gc * 16 + (r & 15))) * 8 + (seg & 1) * 4) = w; }
          } else if (mat == 1) {
              u32x4 w0, w1; w0.x = pk2(a[0], a[1]); w0.y = pk2(a[2], a[3]); w0.z = pk2(a[4], a[5]); w0.w = pk2(a[6], a[7]); w1.x = pk2(a[8], a[9]); w1.y = pk2(a[10], a[11]); w1.z = pk2(a[12], a[13]); w1.w = pk2(a[14], a[15]);
              *(LAS u32x4*)(Ks + r * 136 + seg * 16) = w0; *(LAS u32x4*)(Ks + r * 136 + seg * 16 + 8) = w1;
              const float s1 = br * eg, s2 = __expf(G63 - Gr);
#pragma unroll
              for (int c = 0; c < 16; ++c) { KbT[(seg * 16 + c) * 72 + r] = (bf16)f2bf(a[c] * s1); KtT[(seg * 16 + c) * 72 + r] = (bf16)f2bf(a[c] * s2); }
          } else {
#pragma unroll
              for (int c = 0; c < 16; ++c) VbT[(seg * 16 + c) * 72 + r] = (bf16)f2bf(a[c] * br);
          }
      }
    }
    __syncthreads();
    { const int tt = wave & 3; const bool iskk = wave >= 4;
      LAS bf16* Bsrc = iskk ? Ks : Qs;
      f32x4 d[4];
#pragma unroll
      for (int st = 0; st < 4; ++st) d[st] = (f32x4){0.f, 0.f, 0.f, 0.f};
#pragma unroll
      for (int ks = 0; ks < 4; ++ks) { const bf16x8 bf = *(const LAS bf16x8*)(Bsrc + (tt * 16 + li) * 136 + ks * 32 + lq * 8);
#pragma unroll
          for (int st = 0; st < 4; ++st) { const bf16x8 af = *(const LAS bf16x8*)(Ks + (st * 16 + li) * 136 + ks * 32 + lq * 8); d[st] = mma16(af, bf, d[st]); } }
      const int t = tt * 16 + li; const float Gt = Gs[t], bti = Bs[t];
      if (!iskk) { bf16* qk = (bf16*)(cha + 49152);
#pragma unroll
          for (int ks = 0; ks < 2; ++ks) { float v[8];
#pragma unroll
              for (int hh = 0; hh < 2; ++hh)
#pragma unroll
                  for (int r = 0; r < 4; ++r) { const int s = (2 * ks + hh) * 16 + 4 * lq + r; v[hh * 4 + r] = (s <= t) ? d[2 * ks + hh][r] * __expf(Gt - Gs[s]) : 0.f; }
              u32x4 w; w.x = pk2(v[0], v[1]); w.y = pk2(v[2], v[3]); w.z = pk2(v[4], v[5]); w.w = pk2(v[6], v[7]);
              *(u32x4*)(qk + ((size_t)((tt * 2 + ks) * 64 + lane)) * 8) = w; }
      } else {
#pragma unroll
          for (int st = 0; st < 4; ++st) { f32x4 v;
#pragma unroll
              for (int r = 0; r < 4; ++r) { const int j = st * 16 + 4 * lq + r; v[r] = (t > j) ? bti * d[st][r] * __expf(Gt - Gs[j]) : 0.f; }
              *(LAS f32x4*)(Lm + t * 68 + st * 16 + 4 * lq) = v; }
      }
    }
    __syncthreads();
    { const int cl = lane >> 3, kk = lane & 7, c = wave * 8 + cl;
      float Tr[8];
#pragma unroll
      for (int m = 0; m < 8; ++m) Tr[m] = 0.f;
#pragma unroll
      for (int i = 0; i < 64; ++i) { float s = 0.f;
#pragma unroll
          for (int m = 0; m < 8; ++m) if (8 * m < i) s += Lm[i * 68 + 8 * m + kk] * Tr[m];
          s += __shfl_xor(s, 1); s += __shfl_xor(s, 2); s += __shfl_xor(s, 4);
          const float tv = (i == c ? 1.f : 0.f) - s;
          if (kk == (i & 7)) Tr[i >> 3] = tv; }
#pragma unroll
      for (int m = 0; m < 8; ++m) Tm[(8 * m + kk) * 72 + c] = (bf16)f2bf(Tr[m]);
    }
    __syncthreads();
    { bf16x8 tf[4][2];
#pragma unroll
      for (int tt = 0; tt < 4; ++tt)
#pragma unroll
          for (int ks = 0; ks < 2; ++ks) tf[tt][ks] = *(const LAS bf16x8*)(Tm + (tt * 16 + li) * 72 + ks * 32 + lq * 8);
      bf16x8 vf[2], kf[2];
#pragma unroll
      for (int ks = 0; ks < 2; ++ks) { vf[ks] = *(const LAS bf16x8*)(VbT + (wave * 16 + li) * 72 + ks * 32 + lq * 8); kf[ks] = *(const LAS bf16x8*)(KbT + (wave * 16 + li) * 72 + ks * 32 + lq * 8); }
      f32x4* vald = (f32x4*)(F.ws + WS_VALD + (size_t)unit * 32768);
      bf16* nkc = (bf16*)cha;
#pragma unroll
      for (int tt = 0; tt < 4; ++tt) {
          f32x4 dv = (f32x4){0.f, 0.f, 0.f, 0.f}, dk = (f32x4){0.f, 0.f, 0.f, 0.f};
#pragma unroll
          for (int ks = 0; ks < 2; ++ks) { dv = mma16(tf[tt][ks], vf[ks], dv); dk = mma16(kf[ks], tf[tt][ks], dk); }
          vald[(wave * 4 + tt) * 64 + lane] = dv;
          u32x2 w; w.x = pk2(-dk[0], -dk[1]); w.y = pk2(-dk[2], -dk[3]);
          *(u32x2*)(nkc + ((size_t)((tt * 4 + (wave >> 1)) * 64 + lane)) * 8 + (wave & 1) * 4) = w;
      }
      bf16* ktg = (bf16*)(cha + 32768);
#pragma unroll
      for (int f = 0; f < 2; ++f) { const int fi = wave * 2 + f, mt = fi >> 1, ks = fi & 1;
          const u32x2 lo = *(const LAS u32x2*)(KtT + (mt * 16 + li) * 72 + ks * 32 + 4 * lq), hi = *(const LAS u32x2*)(KtT + (mt * 16 + li) * 72 + ks * 32 + 16 + 4 * lq);
          u32x4 w; w.x = lo.x; w.y = lo.y; w.z = hi.x; w.w = hi.y;
          *(u32x4*)(ktg + ((size_t)(fi * 64 + lane)) * 8) = w; }
    }
    __syncthreads();
}

__device__ __forceinline__ void gdn_seq(Frame& F, int wgi) {
    const int bh = wgi >> 1, half = wgi & 1, b = bh >> 2, h = bh & 3, wave = F.wave, lane = F.lane, li = lane & 15, lq = lane >> 4;
    const unsigned char* cha = F.ws + WS_CHA + (size_t)bh * 64 * CHA_BYTES;
    const float* glp = WSP(float, WS_GL) + bh * 64;
    LAS unsigned char* buf = F.lds;
    if (wave >= 4) {
        const int lt = F.tid - 256;
        u32x4 rg[14];
#pragma unroll
        for (int k = 0; k < 14; ++k) rg[k] = *(const u32x4*)(cha + (size_t)(lt + 256 * k) * 16);
#pragma unroll
        for (int k = 0; k < 14; ++k) *(LAS u32x4*)(buf + (lt + 256 * k) * 16) = rg[k];
#pragma unroll
        for (int k = 0; k < 14; ++k) rg[k] = *(const u32x4*)(cha + CHA_BYTES + (size_t)(lt + 256 * k) * 16);
        __syncthreads();
        for (int n = 0; n < 64; ++n) {
            if (n + 1 < 64) {
#pragma unroll
                for (int k = 0; k < 14; ++k) *(LAS u32x4*)(buf + ((n + 1) & 1) * CHA_BYTES + (lt + 256 * k) * 16) = rg[k];
                if (n + 2 < 64) {
#pragma unroll
                    for (int k = 0; k < 14; ++k) rg[k] = *(const u32x4*)(cha + (size_t)(n + 2) * CHA_BYTES + (size_t)(lt + 256 * k) * 16);
                }
            }
            __syncthreads();
        }
    } else {
        const int sl = half * 4 + wave;
        const f32x4* vald = (const f32x4*)(F.ws + WS_VALD + (size_t)bh * 64 * 32768) + sl * 256 + lane;
        float* og = WSP(float, WS_O) + (size_t)(b * SEQ) * 512 + h * 128 + sl * 16 + li;
        f32x4 S[8];
#pragma unroll
        for (int d = 0; d < 8; ++d) S[d] = (f32x4){0.f, 0.f, 0.f, 0.f};
        f32x4 vn[4];
#pragma unroll
        for (int tt = 0; tt < 4; ++tt) vn[tt] = vald[tt * 64];
        float gln = glp[0];
        __syncthreads();
        for (int n = 0; n < 64; ++n) {
            const LAS unsigned char* bb = buf + (n & 1) * CHA_BYTES + lane * 16;
            f32x4 W[4]; const float gl = gln;
#pragma unroll
            for (int tt = 0; tt < 4; ++tt) W[tt] = vn[tt];
            if (n + 1 < 64) {
#pragma unroll
                for (int tt = 0; tt < 4; ++tt) vn[tt] = vald[(size_t)(n + 1) * 2048 + tt * 64];
                gln = glp[n + 1];
            }
            bf16x8 Sb[4];
#pragma unroll
            for (int ks = 0; ks < 4; ++ks) Sb[ks] = pack8(S[2 * ks], S[2 * ks + 1]);
            f32x4 O[4];
#pragma unroll
            for (int tt = 0; tt < 4; ++tt) { O[tt] = (f32x4){0.f, 0.f, 0.f, 0.f};
#pragma unroll
                for (int ks = 0; ks < 4; ++ks) { const bf16x8 a = *(const LAS bf16x8*)(bb + (tt * 4 + ks) * 1024); W[tt] = mma16(a, Sb[ks], W[tt]);
                    const bf16x8 q = *(const LAS bf16x8*)(bb + 16384 + (tt * 4 + ks) * 1024); O[tt] = mma16(q, Sb[ks], O[tt]); } }
            bf16x8 Vb[2];
#pragma unroll
            for (int ks = 0; ks < 2; ++ks) Vb[ks] = pack8(W[2 * ks], W[2 * ks + 1]);
#pragma unroll
            for (int tt = 0; tt < 4; ++tt)
#pragma unroll
                for (int ks = 0; ks < 2; ++ks) { const bf16x8 a = *(const LAS bf16x8*)(bb + 49152 + (tt * 2 + ks) * 1024); O[tt] = mma16(a, Vb[ks], O[tt]); }
#pragma unroll
            for (int d = 0; d < 8; ++d) { S[d] = S[d] * gl;
#pragma unroll
                for (int ks = 0; ks < 2; ++ks) { const bf16x8 a = *(const LAS bf16x8*)(bb + 32768 + (d * 2 + ks) * 1024); S[d] = mma16(a, Vb[ks], S[d]); } }
            float* op = og + (size_t)(n * GC) * 512;
#pragma unroll
            for (int tt = 0; tt < 4; ++tt)
#pragma unroll
                for (int r = 0; r < 4; ++r) op[(size_t)(tt * 16 + 4 * lq + r) * 512] = O[tt][r];
            __syncthreads();
        }
    }
}

__device__ __forceinline__ void gdn_out(Frame& F, int c, int G) {
    const float* o = WSP(float, WS_O); const bf16* z = WSP(bf16, WS_Z); bf16* cc = WSP(bf16, WS_AIN); const float* gn = F.in[I_GNG];
    const int seg = F.tid & 7;
    f32x4 gv[4];
#pragma unroll
    for (int j = 0; j < 4; ++j) gv[j] = *(const f32x4*)(gn + seg * 16 + 4 * j);
    for (int it = c; it < M * NH / 64; it += G) {
        const int p = it * 64 + (F.tid >> 3), tok = p >> 2, hh = p & 3;
        const float* op = o + (size_t)tok * 512 + hh * 128 + seg * 16;
        f32x4 v[4]; float ss = 0.f;
#pragma unroll
        for (int j = 0; j < 4; ++j) { v[j] = *(const f32x4*)(op + 4 * j); ss += (v[j].x * v[j].x + v[j].y * v[j].y) + (v[j].z * v[j].z + v[j].w * v[j].w); }
        ss += __shfl_xor(ss, 1); ss += __shfl_xor(ss, 2); ss += __shfl_xor(ss, 4);
        const float rstd = 1.f / sqrtf(ss * (1.f / 128.f) + EPS);
        const bf16* zp = z + (size_t)tok * 512 + hh * 128 + seg * 16; const u32x4 z0 = *(const u32x4*)zp, z1 = *(const u32x4*)(zp + 8);
        float zz[16] = {bflo(z0.x), bfhi(z0.x), bflo(z0.y), bfhi(z0.y), bflo(z0.z), bfhi(z0.z), bflo(z0.w), bfhi(z0.w), bflo(z1.x), bfhi(z1.x), bflo(z1.y), bfhi(z1.y), bflo(z1.z), bfhi(z1.z), bflo(z1.w), bfhi(z1.w)};
        float r[16];
#pragma unroll
        for (int j = 0; j < 4; ++j)
#pragma unroll
            for (int q = 0; q < 4; ++q) r[4 * j + q] = v[j][q] * rstd * gv[j][q] * siluf_(zz[4 * j + q]);
        u32x4 w0, w1; w0.x = pk2(r[0], r[1]); w0.y = pk2(r[2], r[3]); w0.z = pk2(r[4], r[5]); w0.w = pk2(r[6], r[7]); w1.x = pk2(r[8], r[9]); w1.y = pk2(r[10], r[11]); w1.z = pk2(r[12], r[13]); w1.w = pk2(r[14], r[15]);
        bf16* dp = cc + (size_t)tok * D + 512 + hh * 128 + seg * 16; *(u32x4*)dp = w0; *(u32x4*)(dp + 8) = w1;
    }
}

__device__ __forceinline__ void p7_route(Frame& F) {
    const float* hbuf = F.out; const float* g2 = F.in[I_N2G]; const float* mod = WSP(float, WS_MOD);
    LAS float* wr = (LAS float*)F.lds;
    { const float* wg = F.in[I_WRG]; const float* we = F.in[I_WRE];
      for (int i = F.tid; i < 4096; i += 512) { const int k = i >> 2, j = i & 3; wr[j * 1024 + k] = wg[i]; }
      for (int i = F.tid; i < 32768; i += 512) { const int k = i >> 5, j = i & 31; wr[(4 + j) * 1024 + k] = we[i]; } }
    __syncthreads();
    bf16* min_ = WSP(bf16, WS_AIN); unsigned* cnt = (unsigned*)(F.ws + WS_CTL) + CW_CNT; unsigned* ltok = WSP(unsigned, WS_LTOK); float* lw = WSP(float, WS_LW);
    const int lane = F.lane, gw = F.vcu * 8 + F.wave, NGW = F.G * 8;
    for (int m = gw; m < M; m += NGW) {
        const int b = m >> 12;
        const f32x4* xr = (const f32x4*)(hbuf + (size_t)m * D) + lane;
        f32x4 v[4]; float ss = 0.f;
#pragma unroll
        for (int j = 0; j < 4; ++j) { v[j] = xr[64 * j]; ss += (v[j].x * v[j].x + v[j].y * v[j].y) + (v[j].z * v[j].z + v[j].w * v[j].w); }
        const float rstd = 1.f / sqrtf(wave_sum(ss) * (1.f / D) + EPS);
        u32x2* o8 = (u32x2*)(min_ + (size_t)m * D) + lane;
#pragma unroll
        for (int j = 0; j < 4; ++j) { const int k = 4 * lane + 256 * j;
            const f32x4 gv = *(const f32x4*)(g2 + k), sh = *(const f32x4*)(mod + b * 6144 + 3072 + k), sc = *(const f32x4*)(mod + b * 6144 + 4096 + k);
            v[j] = v[j] * rstd * gv * (sc + 1.f) + sh;
            u32x2 w; w.x = pk2(v[j].x, v[j].y); w.y = pk2(v[j].z, v[j].w); o8[64 * j] = w; }
        float logit = 0.f;
#pragma unroll 1
        for (int q = 0; q < 36; ++q) { float s = 0.f;
#pragma unroll
            for (int j = 0; j < 4; ++j) { const f32x4 wv = *(const LAS f32x4*)(wr + q * 1024 + 4 * lane + 256 * j); s += (v[j].x * wv.x + v[j].y * wv.y) + (v[j].z * wv.z + v[j].w * wv.w); }
            s = wave_sum(s); logit = (lane == q) ? s : logit; }
        float gl4[4];
#pragma unroll
        for (int q = 0; q < 4; ++q) gl4[q] = __shfl(logit, q);
        int grp = 0; float gm = gl4[0];
#pragma unroll
        for (int q = 1; q < 4; ++q) if (gl4[q] > gm) { gm = gl4[q]; grp = q; }
        float den = 0.f;
#pragma unroll
        for (int q = 0; q < 4; ++q) den += expf(gl4[q] - gm);
        const float pgrp = 1.f / den;
        float sv[8];
#pragma unroll
        for (int q = 0; q < 8; ++q) sv[q] = __shfl(logit, 4 + grp * 8 + q);
        int i1 = 0; float v1 = sv[0];
#pragma unroll
        for (int q = 1; q < 8; ++q) if (sv[q] > v1) { v1 = sv[q]; i1 = q; }
        int i2 = -1; float v2 = -3.4e38f;
#pragma unroll
        for (int q = 0; q < 8; ++q) if (q != i1 && sv[q] > v2) { v2 = sv[q]; i2 = q; }
        const float e2 = expf(v2 - v1), w1 = pgrp / (1.f + e2), w2 = pgrp * e2 / (1.f + e2);
        if (lane == 0) {
            const int ex1 = grp * 8 + i1, ex2 = grp * 8 + i2;
            const unsigned s1 = __hip_atomic_fetch_add(cnt + 64 * ex1, 1u, __ATOMIC_RELAXED, __HIP_MEMORY_SCOPE_AGENT);
            const unsigned s2 = __hip_atomic_fetch_add(cnt + 64 * ex2, 1u, __ATOMIC_RELAXED, __HIP_MEMORY_SCOPE_AGENT);
            ltok[(size_t)ex1 * CAP + s1] = (unsigned)m; lw[(size_t)ex1 * CAP + s1] = w1;
            ltok[(size_t)ex2 * CAP + s2] = (unsigned)m | 0x80000000u; lw[(size_t)ex2 * CAP + s2] = w2;
        }
    }
}

__device__ __forceinline__ void moe_tile_table(Frame& F) {
    if (F.tid < 64) { const unsigned* cnt = (const unsigned*)(F.ws + WS_CTL) + CW_CNT;
        unsigned nt = F.lane < 32 ? (__hip_atomic_load(cnt + 64 * F.lane, __ATOMIC_RELAXED, __HIP_MEMORY_SCOPE_AGENT) + 255u) >> 8 : 0u;
        unsigned inc = nt;
#pragma unroll
        for (int d = 1; d < 64; d <<= 1) { const unsigned o = __shfl_up(inc, d); if (F.lane >= d) inc += o; }
        if (F.lane < 32) F.MISC[16 + F.lane] = inc - nt;
        if (F.lane == 31) F.MISC[48] = inc; }
    __syncthreads();
}

__device__ __forceinline__ void p10_final(Frame& F) {
    float* out = F.out; const float* mod = WSP(float, WS_MOD); const float* nf = F.in[I_NFG]; const bf16* ys = WSP(bf16, WS_YSLOT);
    const int lane = F.lane, gw = F.vcu * 8 + F.wave, NGW = F.G * 8;
    for (int m = gw; m < M; m += NGW) {
        const int b = m >> 12;
        f32x4* xr = (f32x4*)(out + (size_t)m * D) + lane;
        const u32x2* y0 = (const u32x2*)(ys + (size_t)m * D) + lane; const u32x2* y1 = (const u32x2*)(ys + ((size_t)M + m) * D) + lane;
        f32x4 v[4]; float ss = 0.f;
#pragma unroll
        for (int j = 0; j < 4; ++j) { const int k = 4 * lane + 256 * j; const f32x4 gt = *(const f32x4*)(mod + b * 6144 + 5120 + k); const u32x2 a = y0[64 * j], c = y1[64 * j];
            f32x4 y; y.x = bflo(a.x) + bflo(c.x); y.y = bfhi(a.x) + bfhi(c.x); y.z = bflo(a.y) + bflo(c.y); y.w = bfhi(a.y) + bfhi(c.y);
            v[j] = xr[64 * j] + gt * y; ss += (v[j].x * v[j].x + v[j].y * v[j].y) + (v[j].z * v[j].z + v[j].w * v[j].w); }
        const float rstd = 1.f / sqrtf(wave_sum(ss) * (1.f / D) + EPS);
#pragma unroll
        for (int j = 0; j < 4; ++j) { const f32x4 gv = *(const f32x4*)(nf + 4 * lane + 256 * j); xr[64 * j] = v[j] * rstd * gv; }
    }
}

constexpr int N_PHASES = 11;
__global__ void __launch_bounds__(512, 2) hymba_fwd(Args args) {
    extern __shared__ __attribute__((aligned(16))) unsigned char lds[];
    Frame F;
    F.lds = (LAS unsigned char*)lds; F.MISC = (volatile LAS unsigned*)(F.lds + MISC_OFF);
    F.tid = threadIdx.x; F.lane = F.tid & 63; F.wave = __builtin_amdgcn_readfirstlane(F.tid >> 6);
    F.G = gridDim.x; { const int bx = blockIdx.x; F.vcu = (F.G % 8 == 0) ? (bx % 8) * (F.G / 8) + bx / 8 : bx; }
#pragma unroll
    for (int i = 0; i < 28; ++i) F.in[i] = args.in[i];
    F.out = args.out; F.ws = args.ws;
    for (int u = F.tid; u < 256; u += 512) F.MISC[u] = 0u;
    __syncthreads();
    XcdBarrier bar; bar.bar = (unsigned*)(F.ws + WS_CTL) + CW_BAR; bar.x = 0; bar.st = nullptr;
    if (MK_N_LAUNCHES == 1) bar = xcd_barrier_post((unsigned*)(F.ws + WS_CTL) + CW_BAR, F.MISC + 8);
    const int lo = args.ph_lo, hi = args.ph_hi;
#ifdef ONLY_PHASE
#define IN(k) ((k) == ONLY_PHASE && lo <= (k) && (k) < hi)
#else
#define IN(k) (lo <= (k) && (k) < hi)
#endif
#define SEAM(k) do { if (IN(k) && IN((k) + 1)) xcd_barrier(bar); } while (0)
    const int bx = (int)blockIdx.x;

    if (IN(0)) { p0_prologue(F); } SEAM(0);
    if (IN(1)) { p1_ain(F); } SEAM(1);
    if (IN(2)) {
        SchedDense S; S.T.init(M / 256, N_IN / 256, F.G, bx); S.A = (const char*)WSP(bf16, WS_AIN); S.B = (const char*)WSP(bf16, WS_WIN); S.lda = D; S.ldb = D;
        EpiInProj E{WSP(bf16, WS_AY), WSP(bf16, WS_QKV), WSP(bf16, WS_Z)};
        pg8::gemm_phase<EpiInProj, SchedDense>(F.lds, D, D, S, E);
    } SEAM(2);
    if (IN(3)) {
        if (F.vcu < 128) s5_state_unit(F, F.vcu);
        for (int u = F.vcu; u < 1024; u += F.G) gdn_prep_unit(F, u);
    } SEAM(3);
    if (IN(4)) {
        if ((F.vcu & 7) == 0 && F.vcu < 256) gdn_seq(F, F.vcu >> 3);
        else { SchedS5Y S; S.G = 128; { const int cc = F.vcu - (F.vcu >> 3) - 1; S.c = cc < 128 ? cc : -1; } S.ay = (const char*)WSP(bf16, WS_AY); S.bty = (const char*)WSP(bf16, WS_BTY);
            EpiS5Y E{F.in[I_S5D], WSP(bf16, WS_YG)};
            pg8::gemm_phase<EpiS5Y, SchedS5Y>(F.lds, KY, KY, S, E); }
    } SEAM(4);
    if (IN(5)) {
        const int ng = F.G >= 256 ? 128 : F.G / 2;
        if (F.vcu < ng) { SchedDense S; S.T.init(M / 256, 2, ng, F.vcu); S.A = (const char*)WSP(bf16, WS_YG); S.B = (const char*)WSP(bf16, WS_WGLU); S.lda = 512; S.ldb = 512;
            EpiGlu E{WSP(bf16, WS_YG), F.in[I_BGLU], WSP(bf16, WS_AIN)};
            pg8::gemm_phase<EpiGlu, SchedDense>(F.lds, 512, 512, S, E); }
        else gdn_out(F, F.vcu - ng, F.G - ng);
    } SEAM(5);
    if (IN(6)) {
        SchedDense S; S.T.init(M / 256, D / 256, F.G, bx); S.A = (const char*)WSP(bf16, WS_AIN); S.B = (const char*)WSP(bf16, WS_WOUT); S.lda = D; S.ldb = D;
        EpiOutProj E{F.in[I_X], WSP(float, WS_MOD), F.out};
        pg8::gemm_phase<EpiOutProj, SchedDense>(F.lds, D, D, S, E);
    } SEAM(6);
    if (IN(7)) { p7_route(F); } SEAM(7);
    if (IN(8)) {
        moe_tile_table(F);
        SchedMoe<1, 2, D> S; S.tb = F.MISC + 16; S.G = F.G; S.c = F.vcu; S.ws = F.ws;
        EpiGateUp E{WSP(bf16, WS_ACT)};
        pg8::gemm_phase<EpiGateUp, SchedMoe<1, 2, D>>(F.lds, D, D, S, E);
    } SEAM(8);
    if (IN(9)) {
        moe_tile_table(F);
        SchedMoe<0, 4, DE> S; S.tb = F.MISC + 16; S.G = F.G; S.c = F.vcu; S.ws = F.ws;
        EpiDown E{F.ws};
        pg8::gemm_phase<EpiDown, SchedMoe<0, 4, DE>>(F.lds, DE, DE, S, E);
    } SEAM(9);
    if (IN(10)) { p10_final(F); }
#undef IN
#undef SEAM
}

extern "C" void kernel_launch(void* const* d_in, const int* in_sizes, int n_in, void* d_out, int out_size, void* d_ws, size_t ws_size, hipStream_t stream) {
    static int grid = 0;
    if (grid == 0) {
        if (n_in != 28 || in_sizes[0] != M * D || out_size != M * D || ws_size < WS_END) { fprintf(stderr, "kernel_launch: unexpected problem (n_in %d, in0 %d, out %d, ws %zu)\n", n_in, n_in > 0 ? in_sizes[0] : -1, out_size, ws_size); grid = -1; return; }
        int dev = 0, cus = 0;
        if (hipGetDevice(&dev) != hipSuccess || hipDeviceGetAttribute(&cus, hipDeviceAttributeMultiprocessorCount, dev) != hipSuccess) { grid = -1; return; }
        if (hipFuncSetAttribute((const void*)hymba_fwd, hipFuncAttributeMaxDynamicSharedMemorySize, LDS_BYTES) != hipSuccess) { fprintf(stderr, "kernel_launch: hipFuncSetAttribute failed\n"); grid = -1; return; }
        int per_cu = 0;
        if (hipOccupancyMaxActiveBlocksPerMultiprocessor(&per_cu, (const void*)hymba_fwd, 512, LDS_BYTES) != hipSuccess || per_cu < 1) fprintf(stderr, "kernel_launch: occupancy query reports %d\n", per_cu);
        (void)hipGetLastError();
        grid = cus;
    }
    if (grid < 0) return;
    if (hipMemsetAsync((char*)d_ws + WS_CTL, 0, CTL_ZERO_BYTES, stream) != hipSuccess) return;
    Args a{};
    for (int i = 0; i < 28; ++i) a.in[i] = (const float*)d_in[i];
    a.out = (float*)d_out; a.ws = (unsigned char*)d_ws;
    if (MK_N_LAUNCHES == 1) { a.ph_lo = 0; a.ph_hi = N_PHASES; hipLaunchKernelGGL(hymba_fwd, dim3(grid), dim3(512), LDS_BYTES, stream, a); }
    else for (int p = 0; p < N_PHASES; ++p) { a.ph_lo = p; a.ph_hi = p + 1; hipLaunchKernelGGL(hymba_fwd, dim3(grid), dim3(512), LDS_BYTES, stream, a); }
}
```

```cpp
#include <hip/hip_runtime.h>
#include <cstdio>
#include <cstdint>

#ifndef MK_N_LAUNCHES
#define MK_N_LAUNCHES 1
#endif

#define LAS __attribute__((address_space(3)))
#define GAS __attribute__((address_space(1)))
typedef unsigned short bf16;
typedef short bf16x8 __attribute__((ext_vector_type(8)));
typedef float f32x4 __attribute__((ext_vector_type(4)));
typedef float f32x2 __attribute__((ext_vector_type(2)));
typedef unsigned u32x4 __attribute__((ext_vector_type(4)));
typedef unsigned u32x2 __attribute__((ext_vector_type(2)));
typedef GAS unsigned gu32;

constexpr int BATCH = 4, SEQ = 4096, D = 1024, M = BATCH * SEQ;
constexpr int D_S5 = 512, NG = 32, SP = 64, D_GDN = 512, NH = 4, HD = 128, D_IN = 2568, N_IN = 2560;
constexpr int NE = 32, DE = 256, CS = 16  , NCH = SEQ / CS  , GC = 64  ;
constexpr int KY = 384;
constexpr int CAP = 16384;
constexpr float EPS = 1e-6f;

constexpr size_t MiB = 1u << 20;
constexpr size_t WS_CTL = 0, CTL_ZERO_BYTES = 1 * MiB;
constexpr size_t WS_MOD = 128 * 1024;
constexpr size_t WS_LAM16 = 1 * MiB + 128 * 1024;
constexpr size_t WS_GL = 1 * MiB + 160 * 1024;
constexpr size_t WS_GG = 1 * MiB + 256 * 1024;
constexpr size_t WS_BETA = 1 * MiB + 512 * 1024;
constexpr size_t WS_WIN = 2 * MiB;
constexpr size_t WS_WGLU = 7 * MiB;
constexpr size_t WS_WOUT = 8 * MiB;
constexpr size_t WS_BTY = 10 * MiB;
constexpr size_t WS_WZT = 16 * MiB;
constexpr size_t WS_WGU = 18 * MiB;
constexpr size_t WS_WD = 50 * MiB;
constexpr size_t WS_AIN = 66 * MiB;
constexpr size_t WS_VALD = WS_AIN;
constexpr size_t WS_AY = 98 * MiB;
constexpr size_t WS_ACT = WS_AY;
constexpr size_t WS_QKV = 122 * MiB;
constexpr size_t WS_O = 122 * MiB;
constexpr size_t WS_YG = 154 * MiB;
constexpr size_t WS_Z = 170 * MiB;
constexpr size_t WS_YSLOT = 122 * MiB;
constexpr size_t WS_CHA = 186 * MiB;
constexpr size_t WS_LTOK = 242 * MiB;
constexpr size_t WS_LW = 244 * MiB;
constexpr size_t WS_DUMP = 246 * MiB;
constexpr size_t WS_END = 256 * MiB;
constexpr int CHA_BYTES = 57344;
constexpr int CW_BAR = 4096;
constexpr int CW_CNT = 8192;
constexpr int CW_Q3 = 12288;

constexpr int LDS_BYTES = 163840;
constexpr int MISC_OFF = LDS_BYTES - 1024;

#define LDS_WAIT() asm volatile("s_waitcnt lgkmcnt(0)" ::: "memory")
#define VM_WAIT() asm volatile("s_waitcnt vmcnt(0)" ::: "memory")
__device__ __forceinline__ unsigned f2bf(float f) { unsigned u = __builtin_bit_cast(unsigned, f); return (u + 0x7fffu + ((u >> 16) & 1u)) >> 16; }
__device__ __forceinline__ unsigned pk2(float lo, float hi) { return f2bf(lo) | (f2bf(hi) << 16); }
__device__ __forceinline__ float bf2f(unsigned short b) { return __builtin_bit_cast(float, (unsigned)b << 16); }
__device__ __forceinline__ float bflo(unsigned w) { return __builtin_bit_cast(float, w << 16); }
__device__ __forceinline__ float bfhi(unsigned w) { return __builtin_bit_cast(float, w & 0xffff0000u); }
__device__ __forceinline__ float wave_sum(float v) {
#pragma unroll
    for (int o = 1; o < 64; o <<= 1) v += __shfl_xor(v, o);
    return v;
}
__device__ __forceinline__ float sigmoidf_(float x) { return 1.f / (1.f + __expf(-x)); }
__device__ __forceinline__ float siluf_(float x) { return x / (1.f + __expf(-x)); }
__device__ __forceinline__ float gelu_tanh(float x) {
    const float u = 0.7978845608028654f * (x + 0.044715f * x * x * x);
    const float t = 1.f - 2.f / (1.f + __expf(2.f * u));
    return 0.5f * x * (1.f + t);
}
__device__ __forceinline__ float dpp_add8(float s) {
    int t = __builtin_amdgcn_update_dpp(0, __builtin_bit_cast(int, s), 0xB1, 0xF, 0xF, true); s += __builtin_bit_cast(float, t);
    t = __builtin_amdgcn_update_dpp(0, __builtin_bit_cast(int, s), 0x4E, 0xF, 0xF, true); s += __builtin_bit_cast(float, t);
    t = __builtin_amdgcn_update_dpp(0, __builtin_bit_cast(int, s), 0x141, 0xF, 0xF, true); s += __builtin_bit_cast(float, t);
    return s;
}
__device__ __forceinline__ f32x4 mma16(bf16x8 a, bf16x8 b, f32x4 c) { return __builtin_amdgcn_mfma_f32_16x16x32_bf16(a, b, c, 0, 0, 0); }
__device__ __forceinline__ bf16x8 pack8(f32x4 lo, f32x4 hi) {
    u32x4 w; w.x = pk2(lo.x, lo.y); w.y = pk2(lo.z, lo.w); w.z = pk2(hi.x, hi.y); w.w = pk2(hi.z, hi.w);
    return __builtin_bit_cast(bf16x8, w);
}

namespace pg8 {
constexpr int BM = 256, BK = 64, HALF = 128, HTB = HALF * BK * 2, STAGE_BYTES = 8 * HTB;
__device__ __forceinline__ int lds_byte(int r, int c) { const int st = (r >> 4) * 2 + (c >> 5), rr = r & 15, cc = c & 31, ob = rr * 64 + cc * 2; return st * 1024 + (ob ^ (((ob >> 9) & 1) << 5)); }
__device__ __forceinline__ void stage_rc(int b, int& R, int& C) { const int st = b / 1024, sb = b % 1024, swz = sb ^ (((sb >> 9) & 1) << 5); R = (st >> 1) * 16 + swz / 64; C = (st & 1) * 32 + (swz % 64) / 2; }
__device__ __forceinline__ int perm32(int rho) { const int n = rho >> 4, i = rho & 15; return 8 * (i >> 2) + 4 * n + (i & 3); }
__device__ __forceinline__ unsigned cvt_pk_bf16(float lo, float hi) { unsigned r; asm volatile("v_cvt_pk_bf16_f32 %0, %1, %2" : "=v"(r) : "v"(lo), "v"(hi)); return r; }

struct GUnit { const char* A; const char* B; int i0, i1, i2, i3; };

template <class Epi, class Sched>
__device__ __forceinline__ void gemm_phase(LAS unsigned char* lds, const int K, const int ldb, const Sched& S, const Epi& E) {
    const int tid = threadIdx.x, wid = __builtin_amdgcn_readfirstlane(tid >> 6), lane = tid & 63, wr = wid >> 2, wc = wid & 3, fr = lane & 15, fq = lane >> 4;
    const int nt = K / BK;
    int RA[2], CA[2]; unsigned voffB[2];
#pragma unroll
    for (int i = 0; i < 2; ++i) { int R, C; stage_rc(tid * 16 + i * 8192, R, C); const int Rb = Epi::PERM ? ((R & ~31) + perm32(R & 31)) : R;
        RA[i] = R; CA[i] = C; voffB[i] = (unsigned)(Rb * ldb + C) * 2u; }
    const size_t kstep = (size_t)(BK * 2);
    const size_t hstepB = (size_t)HALF * ldb * 2;
    const unsigned ldsw = (unsigned)wid * 1024u;
    const int aoff = lds_byte(wr * 64 + fr, fq * 8), boff = lds_byte(wc * 32 + fr, fq * 8);
#define PG8_SA(b, h) (((b) * 2 + (h)) * HTB)
#define PG8_SB(b, h) ((4 + (b) * 2 + (h)) * HTB)
#define PG8_STAGE(bufoff, gbase, voff) do { _Pragma("unroll") for (int _i = 0; _i < 2; ++_i) \
        __builtin_amdgcn_global_load_lds((const unsigned*)((const char*)(gbase) + (voff)[_i]), (LAS unsigned*)(lds + (bufoff) + ldsw + _i * 8192), 16, 0, 0); } while (0)
#define PG8_LDA(dst, b, h) do { _Pragma("unroll") for (int m = 0; m < 4; ++m) _Pragma("unroll") for (int k = 0; k < 2; ++k) dst[m][k] = *(const LAS bf16x8*)(lds + PG8_SA(b, h) + aoff + m * 2048 + k * 1024); } while (0)
#define PG8_LDB(dst, b, h) do { _Pragma("unroll") for (int n = 0; n < 2; ++n) _Pragma("unroll") for (int k = 0; k < 2; ++k) dst[n][k] = *(const LAS bf16x8*)(lds + PG8_SB(b, h) + boff + n * 2048 + k * 1024); } while (0)
#define PG8_MMA(ai, bj, At, Bt) do { __builtin_amdgcn_s_setprio(1); _Pragma("unroll") for (int m = 0; m < 4; ++m) _Pragma("unroll") for (int n = 0; n < 2; ++n) _Pragma("unroll") for (int k = 0; k < 2; ++k) \
        acc[ai][bj][m][n] = __builtin_amdgcn_mfma_f32_16x16x32_bf16(Bt[n][k], At[m][k], acc[ai][bj][m][n], 0, 0, 0); __builtin_amdgcn_s_setprio(0); } while (0)
#define PG8_WAIT_V(n) asm volatile("s_waitcnt vmcnt(" #n ")" ::: "memory")
#define PG8_WAIT_L(n) asm volatile("s_waitcnt lgkmcnt(" #n ")" ::: "memory")
#define PG8_BAR __builtin_amdgcn_s_barrier()
#define PG8_SCHED __builtin_amdgcn_sched_barrier(0)
    GUnit cur, nxt; int ui = 0;
    if (!S.next(0, cur)) return;
    unsigned vc[2][2], vn[2][2];
#pragma unroll
    for (int h = 0; h < 2; ++h)
#pragma unroll
        for (int i = 0; i < 2; ++i) vc[h][i] = S.arow(cur, h * HALF + RA[i]) + (unsigned)CA[i] * 2u;
    f32x4 acc[2][2][4][2];
#pragma unroll
    for (int a = 0; a < 2; ++a)
#pragma unroll
        for (int b = 0; b < 2; ++b)
#pragma unroll
            for (int m = 0; m < 4; ++m)
#pragma unroll
                for (int n = 0; n < 2; ++n) acc[a][b][m][n] = (f32x4){0.f, 0.f, 0.f, 0.f};
    bf16x8 At[4][2], B0[2][2], B1[2][2];
    const char* cA = cur.A; const char* cB = cur.B;
    PG8_STAGE(PG8_SB(0, 0), cB, voffB); PG8_STAGE(PG8_SB(0, 1), cB + hstepB, voffB); PG8_STAGE(PG8_SA(0, 0), cA, vc[0]); PG8_STAGE(PG8_SA(0, 1), cA, vc[1]);
    if (wr == 1) PG8_BAR;
    PG8_WAIT_V(2); PG8_BAR;
    PG8_STAGE(PG8_SB(1, 0), cB + kstep, voffB); PG8_STAGE(PG8_SA(1, 0), cA + kstep, vc[0]); PG8_STAGE(PG8_SB(1, 1), cB + hstepB + kstep, voffB);
    PG8_WAIT_V(6); PG8_BAR;
    for (;;) {
        const bool has_next = S.next(ui + 1, nxt);
        const char* nA = has_next ? nxt.A : cA; const char* nB = has_next ? nxt.B : cB;
#pragma unroll
        for (int h = 0; h < 2; ++h)
#pragma unroll
            for (int i = 0; i < 2; ++i) vn[h][i] = has_next ? (S.arow(nxt, h * HALF + RA[i]) + (unsigned)CA[i] * 2u) : vc[h][i];
#pragma unroll 1
        for (int t = 0; t < nt; t += 2) {
            const bool last = (t == nt - 2);
            const char* a1 = cA + (size_t)(t + 1) * kstep;
            const char* a2 = last ? nA : cA + (size_t)(t + 2) * kstep; const char* b2 = last ? nB : cB + (size_t)(t + 2) * kstep;
            const char* a3 = a2 + kstep; const char* b3 = b2 + kstep;
            unsigned va2[2][2];
#pragma unroll
            for (int h = 0; h < 2; ++h)
#pragma unroll
                for (int i = 0; i < 2; ++i) va2[h][i] = last ? vn[h][i] : vc[h][i];
            PG8_LDB(B0, 0, 0); PG8_LDB(B1, 0, 1); PG8_SCHED; PG8_LDA(At, 0, 0); PG8_STAGE(PG8_SA(1, 1), a1, vc[1]);
            PG8_WAIT_V(8); PG8_WAIT_L(0); PG8_BAR; PG8_MMA(0, 0, At, B0); PG8_MMA(0, 1, At, B1); PG8_BAR; PG8_SCHED;
            PG8_LDA(At, 0, 1); PG8_STAGE(PG8_SB(0, 0), b2, voffB); PG8_STAGE(PG8_SB(0, 1), b2 + hstepB, voffB); PG8_STAGE(PG8_SA(0, 0), a2, va2[0]);
            PG8_WAIT_V(8); PG8_WAIT_L(0); PG8_BAR; PG8_MMA(1, 0, At, B0); PG8_MMA(1, 1, At, B1); PG8_BAR; PG8_SCHED;
            PG8_LDB(B0, 1, 0); PG8_LDB(B1, 1, 1); PG8_SCHED; PG8_LDA(At, 1, 0); PG8_STAGE(PG8_SA(0, 1), a2, va2[1]);
            PG8_WAIT_V(8); PG8_WAIT_L(0); PG8_BAR; PG8_MMA(0, 0, At, B0); PG8_MMA(0, 1, At, B1); PG8_BAR; PG8_SCHED;
            PG8_LDA(At, 1, 1); PG8_STAGE(PG8_SB(1, 0), b3, voffB); PG8_STAGE(PG8_SB(1, 1), b3 + hstepB, voffB); PG8_STAGE(PG8_SA(1, 0), a3, va2[0]);
            PG8_WAIT_V(8); PG8_WAIT_L(0); PG8_BAR; PG8_MMA(1, 0, At, B0); PG8_MMA(1, 1, At, B1); PG8_BAR; PG8_SCHED;
        }
        if (wr == 0) PG8_BAR;
        E(acc, cur, wr, wc, fr, fq);
        if (!has_next) break;
#pragma unroll
        for (int a = 0; a < 2; ++a)
#pragma unroll
            for (int b = 0; b < 2; ++b)
#pragma unroll
                for (int m = 0; m < 4; ++m)
#pragma unroll
                    for (int n = 0; n < 2; ++n) acc[a][b][m][n] = (f32x4){0.f, 0.f, 0.f, 0.f};
        cur = nxt; cA = nA; cB = nB; ++ui;
#pragma unroll
        for (int h = 0; h < 2; ++h)
#pragma unroll
            for (int i = 0; i < 2; ++i) vc[h][i] = vn[h][i];
        if (wr == 1) PG8_BAR;
    }
    PG8_WAIT_V(0);
    PG8_BAR;
#undef PG8_SA
#undef PG8_SB
#undef PG8_STAGE
#undef PG8_LDA
#undef PG8_LDB
#undef PG8_MMA
#undef PG8_WAIT_V
#undef PG8_WAIT_L
#undef PG8_BAR
#undef PG8_SCHED
}

struct TileOrder {
    int nM, nN, nwg, G, c;
    __device__ void init(int nM_, int nN_, int G_, int c_) { nM = nM_; nN = nN_; nwg = nM * nN; G = G_; c = c_; }
    __device__ bool tile(int i, int& pm, int& pn) const {
        const long L = (long)i * G + c; if (c < 0 || L >= nwg) return false;
        int wgid = (int)L; { const int q = nwg / 8, r = nwg % 8, xcd = wgid % 8, off = wgid / 8; wgid = (xcd < r ? xcd * (q + 1) : r * (q + 1) + (xcd - r) * q) + off; }
        const int nig = 8 * nN, gid = wgid / nig, fm = gid * 8, gsz = (nM - fm) < 8 ? (nM - fm) : 8;
        pm = fm + ((wgid % nig) % gsz); pn = (wgid % nig) / gsz; return true;
    }
};
}
using pg8::GUnit;

#define XB_TMO      128
#define XB_XCNT(j)  (256  + 64 * (j))
#define XB_XSUB(j)  (1280 + 64 * (j))
#define XB_XGEN(j)  (2304 + 64 * (j))
#define XB_TOP      3328
#define XB_TOPGEN   3392
#define XCD_BAR_WORDS 3456
#define XB_SPIN_CAP (1u << 18)
__device__ __forceinline__ unsigned xb_ld(unsigned* p)              { return __hip_atomic_load(p, __ATOMIC_RELAXED, __HIP_MEMORY_SCOPE_AGENT); }
__device__ __forceinline__ unsigned xb_add(unsigned* p, unsigned v) { return __hip_atomic_fetch_add(p, v, __ATOMIC_RELAXED, __HIP_MEMORY_SCOPE_AGENT); }
__device__ __forceinline__ unsigned xb_xcc_id() { return (unsigned)__builtin_amdgcn_s_getreg((3 << 11) | 20) & 0xFu; }
#define XB_SPIN(cond, bar) do { unsigned _sp = 0; while (cond) { __builtin_amdgcn_s_sleep(1); \
    if ((++_sp & 255u) == 0u) { if (xb_ld(&(bar)[XB_TMO])) break; if (_sp > XB_SPIN_CAP) { atomicAdd(&(bar)[XB_TMO], 1u); break; } } } } while (0)
struct XcdBarrier { unsigned* bar; unsigned x; volatile LAS unsigned* st; };
__device__ __forceinline__ XcdBarrier xcd_barrier_post(unsigned* bar, volatile LAS unsigned* st) {
    XcdBarrier b; b.bar = bar; b.x = xb_xcc_id(); b.st = st;
    if (threadIdx.x == 0) (void)xb_add(&bar[XB_XCNT(b.x)], 1u);
    return b;
}
__device__ __forceinline__ void xcd_barrier_complete(unsigned* bar, unsigned x, unsigned& nloc, unsigned& nx) {
    const unsigned G = gridDim.x * gridDim.y * gridDim.z;
    unsigned sum, cnt, mine, sp = 0u;
    for (;;) {
        sum = 0u; cnt = 0u; mine = 0u;
#pragma unroll
        for (unsigned j = 0; j < 16; ++j) { const unsigned c = xb_ld(&bar[XB_XCNT(j)]); sum += c; cnt += (c > 0u) ? 1u : 0u; mine = (j == x) ? c : mine; }
        if (sum == G) break;
        __builtin_amdgcn_s_sleep(1);
        if ((++sp & 255u) == 0u) { if (xb_ld(&bar[XB_TMO])) break; if (sp > XB_SPIN_CAP) { atomicAdd(&bar[XB_TMO], 1u); break; } }
    }
    nloc = mine > 0u ? mine : 1u; nx = cnt > 0u ? cnt : 1u;
}
__device__ __forceinline__ void xcd_barrier(const XcdBarrier& b) {
    asm volatile("s_waitcnt vmcnt(0)" ::: "memory");
    __syncthreads();
    if (threadIdx.x == 0) {
        unsigned* bar = b.bar;
        __builtin_amdgcn_s_waitcnt(0);
        unsigned nloc = b.st[0], nx = b.st[1];
        if (nloc == 0u) { xcd_barrier_complete(bar, b.x, nloc, nx); b.st[0] = nloc; b.st[1] = nx; }
        const unsigned old = xb_add(&bar[XB_XSUB(b.x)], 1u);
        const unsigned gen = old / nloc;
        if (old + 1u == (gen + 1u) * nloc) {
            __builtin_amdgcn_fence(__ATOMIC_RELEASE, "agent");
            asm volatile("s_waitcnt vmcnt(0)" ::: "memory");
            const unsigned og = xb_add(&bar[XB_TOP], 1u);
            const unsigned tg = og / nx;
            if (og + 1u == (tg + 1u) * nx) xb_add(&bar[XB_TOPGEN], 1u);
            else XB_SPIN(xb_ld(&bar[XB_TOPGEN]) == tg, bar);
            __builtin_amdgcn_fence(__ATOMIC_ACQUIRE, "agent");
            xb_add(&bar[XB_XGEN(b.x)], 1u);
            asm volatile("s_waitcnt vmcnt(0)" ::: "memory");
        } else {
            XB_SPIN(xb_ld(&bar[XB_XGEN(b.x)]) == gen, bar);
            __builtin_amdgcn_fence(__ATOMIC_ACQUIRE, "agent");
            asm volatile("s_waitcnt vmcnt(0)" ::: "memory");
        }
    }
    __syncthreads();
}

struct Args { const float* in[28]; float* out; unsigned char* ws; int ph_lo, ph_hi; };
enum { I_X = 0, I_C, I_N1G, I_N2G, I_WADA, I_BADA, I_WIN, I_LRE, I_LIM, I_LSTEP, I_BRE, I_BIM, I_CRE, I_CIM, I_S5D, I_WGLU, I_BGLU, I_CONVW, I_ALOG, I_DTB, I_GNG, I_WOUT, I_WRG, I_WRE, I_WG, I_WU, I_WDN, I_NFG };

struct Frame {
    LAS unsigned char* lds;
    volatile LAS unsigned* MISC;
    int tid, lane, wave, vcu, G;
    const float* in[28]; float* out;
    unsigned char* ws;
};
#define WSP(T, off) ((T*)(F.ws + (off)))

__device__ __forceinline__ void p0_transpose_item(const float* W, int ldw, int K, bf16* WT, int dst_row0, int k0, int n0, LAS float* scr, int lane) {
    f32x4 v[8];
#pragma unroll
    for (int i = 0; i < 8; ++i) v[i] = *(const f32x4*)(W + (size_t)(k0 + 8 * i + (lane >> 3)) * ldw + n0 + 4 * (lane & 7));
#pragma unroll
    for (int i = 0; i < 8; ++i) { LAS float* d = scr + (8 * i + (lane >> 3)) * 33 + 4 * (lane & 7); d[0] = v[i].x; d[1] = v[i].y; d[2] = v[i].z; d[3] = v[i].w; }
    LDS_WAIT(); asm volatile("" ::: "memory");
    const int c = lane & 7;
#pragma unroll
    for (int j = 0; j < 4; ++j) { const int n = (lane >> 3) + 8 * j; const LAS float* s = scr + (8 * c) * 33 + n;
        u32x4 o; o.x = pk2(s[0 * 33], s[1 * 33]); o.y = pk2(s[2 * 33], s[3 * 33]); o.z = pk2(s[4 * 33], s[5 * 33]); o.w = pk2(s[6 * 33], s[7 * 33]);
        *(u32x4*)(WT + (size_t)(dst_row0 + n) * K + k0 + 8 * c) = o; }
    LDS_WAIT(); asm volatile("" ::: "memory");
}

__device__ __forceinline__ void p0_mod_gemv(Frame& F, int unit) {
    const float* c = F.in[I_C]; const float* wada = F.in[I_WADA]; const float* bada = F.in[I_BADA];
    const int cb = unit % 24, ks = unit / 24, k0 = ks * 128;
    LAS float* cact = (LAS float*)F.lds;
    LAS float* red = (LAS float*)(F.lds + 2048);
    { const int b = F.tid >> 7, k = F.tid & 127; cact[F.tid] = siluf_(c[b * 1024 + k0 + k]); }
    __syncthreads();
    f32x4 acc[4];
#pragma unroll
    for (int b = 0; b < 4; ++b) acc[b] = (f32x4){0.f, 0.f, 0.f, 0.f};
    const float* wp = wada + (size_t)(k0 + F.wave * 16) * 6144 + cb * 256 + 4 * F.lane;
    f32x4 w[16];
#pragma unroll
    for (int k = 0; k < 16; ++k) w[k] = *(const f32x4*)(wp + (size_t)k * 6144);
#pragma unroll
    for (int k = 0; k < 16; ++k)
#pragma unroll
        for (int b = 0; b < 4; ++b) acc[b] += w[k] * cact[b * 128 + F.wave * 16 + k];
#pragma unroll
    for (int b = 0; b < 4; ++b) *(LAS f32x4*)(red + (F.wave * 4 + b) * 256 + 4 * F.lane) = acc[b];
    __syncthreads();
    float* mod = WSP(float, WS_MOD);
#pragma unroll
    for (int o = 0; o < 2; ++o) { const int idx = F.tid + 512 * o, b = idx >> 8, col = idx & 255; float sacc = (ks == 0) ? bada[cb * 256 + col] : 0.f;
#pragma unroll
        for (int wv = 0; wv < 8; ++wv) sacc += red[(wv * 4 + b) * 256 + col];
        atomicAdd(mod + b * 6144 + cb * 256 + col, sacc); }
    __syncthreads();
}

__device__ __forceinline__ void p0_s5_matrices(Frame& F, int g, int hv) {
    const float* lre = F.in[I_LRE] + g * SP; const float* lim = F.in[I_LIM] + g * SP;
    const float* bre = F.in[I_BRE] + (size_t)g * SP * 16; const float* bim = F.in[I_BIM] + (size_t)g * SP * 16;
    const float* cre = F.in[I_CRE] + (size_t)g * 16 * SP; const float* cim = F.in[I_CIM] + (size_t)g * 16 * SP;
    LAS float* lbr = (LAS float*)F.lds;
    LAS float* lbi = lbr + 17 * 64;
    LAS float* bbr = lbi + 17 * 64;
    LAS float* bbi = bbr + 1024;
    LAS float* cr = bbi + 1024;
    LAS float* ci = cr + 1024;
    LAS float* Kt = ci + 1024;
    const double step = exp((double)F.in[I_LSTEP][g]);
    if (F.tid < 64) { const int p = F.tid; const double lr = lre[p], li = lim[p], m = exp(lr * step), br1 = m * cos(li * step), bi1 = m * sin(li * step);
        double pr = 1.0, pi = 0.0;
        for (int n = 0; n <= 16; ++n) { lbr[n * 64 + p] = (float)pr; lbi[n * 64 + p] = (float)pi; const double nr = pr * br1 - pi * bi1, ni = pr * bi1 + pi * br1; pr = nr; pi = ni; }
        const double nr = br1 - 1.0, ni = bi1, den = lr * lr + li * li, qr = (nr * lr + ni * li) / den, qi = (ni * lr - nr * li) / den;
        for (int hp = 0; hp < 16; ++hp) { const double br = bre[p * 16 + hp], bi = bim[p * 16 + hp]; bbr[p * 16 + hp] = (float)(qr * br - qi * bi); bbi[p * 16 + hp] = (float)(qr * bi + qi * br); } }
    for (int idx = F.tid; idx < 1024; idx += 512) { cr[idx] = cre[idx]; ci[idx] = cim[idx]; }
    __syncthreads();
    { const int n = F.tid >> 5, h = (F.tid >> 1) & 15, h8 = (F.tid & 1) * 8; float acc[8];
#pragma unroll
      for (int e = 0; e < 8; ++e) acc[e] = 0.f;
      for (int p = 0; p < 64; ++p) { const float a = cr[h * 64 + p], b = ci[h * 64 + p], lr = lbr[n * 64 + p], li = lbi[n * 64 + p], tr = a * lr - b * li, ti = a * li + b * lr;
          const f32x4 r0 = *(const LAS f32x4*)(bbr + p * 16 + h8), r1 = *(const LAS f32x4*)(bbr + p * 16 + h8 + 4), i0 = *(const LAS f32x4*)(bbi + p * 16 + h8), i1 = *(const LAS f32x4*)(bbi + p * 16 + h8 + 4);
#pragma unroll
          for (int e = 0; e < 4; ++e) { acc[e] += tr * r0[e] - ti * i0[e]; acc[4 + e] += tr * r1[e] - ti * i1[e]; } }
#pragma unroll
      for (int e = 0; e < 8; ++e) Kt[(n * 16 + h) * 16 + h8 + e] = acc[e]; }
    __syncthreads();
    bf16* bty = WSP(bf16, WS_BTY) + (size_t)g * 256 * KY;
    for (int idx = hv * 128 * KY + F.tid; idx < (hv + 1) * 128 * KY; idx += 512) { const int nn = idx / KY, k = idx - nn * KY, t = nn >> 4, h = nn & 15; float v;
        if (k < 256) { const int s = k >> 4, hp = k & 15; v = (t >= s) ? Kt[((t - s) * 16 + h) * 16 + hp] : 0.f; }
        else { const int kk = k - 256, ri = kk >> 6, p = kk & 63; const float a = cr[h * 64 + p], b = ci[h * 64 + p], lr = lbr[(t + 1) * 64 + p], li = lbi[(t + 1) * 64 + p];
            v = ri == 0 ? (a * lr - b * li) : -(a * li + b * lr); }
        bty[idx] = (bf16)f2bf(v); }
    bf16* wzt = WSP(bf16, WS_WZT) + (size_t)g * 128 * 256;
    for (int idx = hv * 64 * 256 + F.tid; idx < (hv + 1) * 64 * 256; idx += 512) { const int nz = idx >> 8, k = idx & 255, ri = nz >> 6, p = nz & 63, s = k >> 4, hp = k & 15;
        const float lr = lbr[(15 - s) * 64 + p], li = lbi[(15 - s) * 64 + p], br = bbr[p * 16 + hp], bi = bbi[p * 16 + hp];
        wzt[idx] = (bf16)f2bf(ri == 0 ? (lr * br - li * bi) : (lr * bi + li * br)); }
    if (hv == 0 && F.tid < 64) { float* l16 = WSP(float, WS_LAM16) + (g * 64 + F.tid) * 2; l16[0] = lbr[16 * 64 + F.tid]; l16[1] = lbi[16 * 64 + F.tid]; }
    __syncthreads();
}

__device__ __forceinline__ void p0_prologue(Frame& F) {
    for (int u = F.vcu; u < 256; u += F.G) { if (u < 192) p0_mod_gemv(F, u); else p0_s5_matrices(F, (u - 192) >> 1, (u - 192) & 1); }
    LAS float* scr = (LAS float*)(F.lds + F.wave * 16384);
    const int gw = F.vcu * 8 + F.wave, NGW = F.G * 8;
    constexpr int I_IN = 16 * 80, I_GLU = 8 * 16, I_OUT = 16 * 32, I_E = 128, I_SMALL = I_IN + I_GLU + I_OUT, NITEMS = I_SMALL + NE * 3 * I_E;
    for (int it = gw; it < NITEMS; it += NGW) {
        int r = it;
        if (r < I_IN) { const int kb = r / 80, nb = r % 80; p0_transpose_item(F.in[I_WIN], D_IN, D, WSP(bf16, WS_WIN), nb * 32, kb * 64, nb * 32, scr, F.lane); continue; } r -= I_IN;
        if (r < I_GLU) { const int kb = r / 16, nb = r % 16; p0_transpose_item(F.in[I_WGLU], 512, 512, WSP(bf16, WS_WGLU), nb * 32, kb * 64, nb * 32, scr, F.lane); continue; } r -= I_GLU;
        if (r < I_OUT) { const int kb = r / 32, nb = r % 32; p0_transpose_item(F.in[I_WOUT], D, D, WSP(bf16, WS_WOUT), nb * 32, kb * 64, nb * 32, scr, F.lane); continue; } r -= I_OUT;
        const int e = r / (3 * I_E), q = r % (3 * I_E), which = q / I_E, j = q % I_E;
        if (which < 2) { const int kb = j / 8, nb = j % 8, n0 = nb * 32;
            p0_transpose_item((which == 0 ? F.in[I_WG] : F.in[I_WU]) + (size_t)e * D * DE, DE, D, WSP(bf16, WS_WGU) + (size_t)e * 512 * D, 256 * (n0 >> 7) + 128 * which + (n0 & 127), kb * 64, n0, scr, F.lane); }
        else { const int kb = j / 32, nb = j % 32;
            p0_transpose_item(F.in[I_WDN] + (size_t)e * DE * D, D, DE, WSP(bf16, WS_WD) + (size_t)e * D * DE, nb * 32, kb * 64, nb * 32, scr, F.lane); }
    }
}

__device__ __forceinline__ void p1_ain(Frame& F) {
    const float* x = F.in[I_X]; const float* g1 = F.in[I_N1G]; const float* win = F.in[I_WIN];
    const float* mod = WSP(float, WS_MOD);
    LAS float* wg = (LAS float*)F.lds;
    for (int i = F.tid; i < 8192; i += 512) { const int k = i >> 3, j = i & 7; wg[j * 1024 + k] = win[(size_t)k * D_IN + N_IN + j]; }
    __syncthreads();
    bf16* ain = WSP(bf16, WS_AIN); float* gg = WSP(float, WS_GG); float* bt = WSP(float, WS_BETA);
    const float* alog = F.in[I_ALOG]; const float* dtb = F.in[I_DTB];
    const int gw = F.vcu * 8 + F.wave, NGW = F.G * 8;
    f32x4 vnx[4];
    if (gw < M) {
#pragma unroll
        for (int j = 0; j < 4; ++j) vnx[j] = ((const f32x4*)(x + (size_t)gw * D) + F.lane)[64 * j]; }
    for (int m = gw; m < M; m += NGW) {
        const int b = m >> 12;
        f32x4 v[4]; float ss = 0.f;
#pragma unroll
        for (int j = 0; j < 4; ++j) { v[j] = vnx[j]; ss += (v[j].x * v[j].x + v[j].y * v[j].y) + (v[j].z * v[j].z + v[j].w * v[j].w); }
        if (m + NGW < M) {
#pragma unroll
            for (int j = 0; j < 4; ++j) vnx[j] = ((const f32x4*)(x + (size_t)(m + NGW) * D) + F.lane)[64 * j]; }
        const float rstd = 1.f / sqrtf(wave_sum(ss) * (1.f / D) + EPS);
        float ga[8];
#pragma unroll
        for (int q = 0; q < 8; ++q) ga[q] = 0.f;
        u32x2* o8 = (u32x2*)(ain + (size_t)m * D) + F.lane;
#pragma unroll
        for (int j = 0; j < 4; ++j) { const int k = 4 * F.lane + 256 * j;
            const f32x4 gv = *(const f32x4*)(g1 + k), sh = *(const f32x4*)(mod + b * 6144 + k), sc = *(const f32x4*)(mod + b * 6144 + 1024 + k);
            f32x4 a = v[j] * rstd * gv * (sc + 1.f) + sh;
            u32x2 w; w.x = pk2(a.x, a.y); w.y = pk2(a.z, a.w); o8[64 * j] = w;
#pragma unroll
            for (int q = 0; q < 8; ++q) { const f32x4 wv = *(const LAS f32x4*)(wg + q * 1024 + k); ga[q] += (a.x * wv.x + a.y * wv.y) + (a.z * wv.z + a.w * wv.w); } }
#pragma unroll
        for (int q = 0; q < 8; ++q) ga[q] = wave_sum(ga[q]);
        if (F.lane < 4) { const int h = F.lane; const float av = (h == 0 ? ga[0] : h == 1 ? ga[1] : h == 2 ? ga[2] : ga[3]) + dtb[h], bv = (h == 0 ? ga[4] : h == 1 ? ga[5] : h == 2 ? ga[6] : ga[7]);
            const float sp = fmaxf(av, 0.f) + log1pf(expf(-fabsf(av)));
            gg[(size_t)m * 4 + h] = -expf(alog[h]) * sp; bt[(size_t)m * 4 + h] = 1.f / (1.f + expf(-bv)); }
    }
}

struct SchedDense {
    pg8::TileOrder T; const char* A; const char* B; int lda, ldb;
    __device__ __forceinline__ bool next(int i, GUnit& u) const { int pm, pn; if (!T.tile(i, pm, pn)) return false;
        u.A = A + (size_t)pm * 256 * lda * 2; u.B = B + (size_t)pn * 256 * ldb * 2; u.i0 = pm; u.i1 = pn; u.i2 = 0; u.i3 = 0; return true; }
    __device__ __forceinline__ unsigned arow(const GUnit&, int r) const { return (unsigned)(r * lda) * 2u; }
};
struct EpiInProj {
    static constexpr bool PERM = true;
    bf16* ay; bf16* qkv; bf16* z;
    __device__ __forceinline__ void operator()(const f32x4 (&acc)[2][2][4][2], const GUnit& u, int wr, int wc, int fr, int fq) const {
        const int pm = u.i0, pn = u.i1;
#pragma unroll
        for (int ai = 0; ai < 2; ++ai)
#pragma unroll
            for (int m = 0; m < 4; ++m) { const int row = pm * 256 + ai * 128 + wr * 64 + m * 16 + fr;
#pragma unroll
                for (int bj = 0; bj < 2; ++bj) { const int col = pn * 256 + bj * 128 + wc * 32 + 8 * fq;
                    const f32x4 v0 = acc[ai][bj][m][0], v1 = acc[ai][bj][m][1];
                    u32x4 w; w.x = pg8::cvt_pk_bf16(v0[0], v0[1]); w.y = pg8::cvt_pk_bf16(v0[2], v0[3]); w.z = pg8::cvt_pk_bf16(v1[0], v1[1]); w.w = pg8::cvt_pk_bf16(v1[2], v1[3]);
                    bf16* dst;
                    if (pn < 2) { const int g = col >> 4, hp = col & 15, b = row >> 12, tl = row & 4095; dst = ay + ((size_t)g * 1024 + b * 256 + (tl >> 4)) * KY + (tl & 15) * 16 + hp; }
                    else if (pn < 8) dst = qkv + (size_t)row * 1536 + (col - 512);
                    else dst = z + (size_t)row * 512 + (col - 2048);
                    *(u32x4*)dst = w; } }
    }
};
struct SchedS5Y {
    int G, c; const char* ay; const char* bty;
    __device__ __forceinline__ bool next(int i, GUnit& u) const { const int L = i * G + c; if (c < 0 || L >= 128) return false; const int g = L >> 2, pm = L & 3;
        u.A = ay + ((size_t)g * 1024 + pm * 256) * KY * 2; u.B = bty + (size_t)g * 256 * KY * 2; u.i0 = pm; u.i1 = g; u.i2 = 0; u.i3 = 0; return true; }
    __device__ __forceinline__ unsigned arow(const GUnit&, int r) const { return (unsigned)(r * KY) * 2u; }
};
struct EpiS5Y {
    static constexpr bool PERM = true;
    const float* s5d; bf16* yg;
    __device__ __forceinline__ void operator()(const f32x4 (&acc)[2][2][4][2], const GUnit& u, int wr, int wc, int fr, int fq) const {
        const int pm = u.i0, g = u.i1;
#pragma unroll
        for (int ai = 0; ai < 2; ++ai)
#pragma unroll
            for (int m = 0; m < 4; ++m) { const int R = pm * 256 + ai * 128 + wr * 64 + m * 16 + fr;
#pragma unroll
                for (int bj = 0; bj < 2; ++bj) { const int n = bj * 128 + wc * 32 + 8 * fq, t = n >> 4, h0 = n & 15;
                    const int token = (R >> 8) * SEQ + (R & 255) * CS + t, ch = g * 16 + h0;
                    const u32x4 uu = *(const u32x4*)(u.A + ((size_t)(ai * 128 + wr * 64 + m * 16 + fr) * KY + n) * 2);
                    const f32x4 d0 = *(const f32x4*)(s5d + ch), d1 = *(const f32x4*)(s5d + ch + 4);
                    const f32x4 v0 = acc[ai][bj][m][0], v1 = acc[ai][bj][m][1];
                    float y[8];
                    y[0] = v0[0] + d0[0] * bflo(uu.x); y[1] = v0[1] + d0[1] * bfhi(uu.x); y[2] = v0[2] + d0[2] * bflo(uu.y); y[3] = v0[3] + d0[3] * bfhi(uu.y);
                    y[4] = v1[0] + d1[0] * bflo(uu.z); y[5] = v1[1] + d1[1] * bfhi(uu.z); y[6] = v1[2] + d1[2] * bflo(uu.w); y[7] = v1[3] + d1[3] * bfhi(uu.w);
#pragma unroll
                    for (int q = 0; q < 8; ++q) y[q] = gelu_tanh(y[q]);
                    u32x4 w; w.x = pg8::cvt_pk_bf16(y[0], y[1]); w.y = pg8::cvt_pk_bf16(y[2], y[3]); w.z = pg8::cvt_pk_bf16(y[4], y[5]); w.w = pg8::cvt_pk_bf16(y[6], y[7]);
                    *(u32x4*)(yg + (size_t)token * 512 + ch) = w; } }
    }
};
struct EpiGlu {
    static constexpr bool PERM = true;
    const bf16* yg; const float* bglu; bf16* cc;
    __device__ __forceinline__ void operator()(const f32x4 (&acc)[2][2][4][2], const GUnit& u, int wr, int wc, int fr, int fq) const {
        const int pm = u.i0, pn = u.i1;
#pragma unroll
        for (int ai = 0; ai < 2; ++ai)
#pragma unroll
            for (int m = 0; m < 4; ++m) { const int row = pm * 256 + ai * 128 + wr * 64 + m * 16 + fr;
#pragma unroll
                for (int bj = 0; bj < 2; ++bj) { const int col = pn * 256 + bj * 128 + wc * 32 + 8 * fq;
                    const u32x4 uu = *(const u32x4*)(yg + (size_t)row * 512 + col);
                    const f32x4 b0 = *(const f32x4*)(bglu + col), b1 = *(const f32x4*)(bglu + col + 4);
                    const f32x4 v0 = acc[ai][bj][m][0] + b0, v1 = acc[ai][bj][m][1] + b1;
                    float y[8];
                    y[0] = bflo(uu.x) * sigmoidf_(v0[0]); y[1] = bfhi(uu.x) * sigmoidf_(v0[1]); y[2] = bflo(uu.y) * sigmoidf_(v0[2]); y[3] = bfhi(uu.y) * sigmoidf_(v0[3]);
                    y[4] = bflo(uu.z) * sigmoidf_(v1[0]); y[5] = bfhi(uu.z) * sigmoidf_(v1[1]); y[6] = bflo(uu.w) * sigmoidf_(v1[2]); y[7] = bfhi(uu.w) * sigmoidf_(v1[3]);
                    u32x4 w; w.x = pg8::cvt_pk_bf16(y[0], y[1]); w.y = pg8::cvt_pk_bf16(y[2], y[3]); w.z = pg8::cvt_pk_bf16(y[4], y[5]); w.w = pg8::cvt_pk_bf16(y[6], y[7]);
                    *(u32x4*)(cc + (size_t)row * D + col) = w; } }
    }
};
struct EpiOutProj {
    static constexpr bool PERM = false;
    const float* x; const float* mod; float* h;
    __device__ __forceinline__ void operator()(const f32x4 (&acc)[2][2][4][2], const GUnit& u, int wr, int wc, int fr, int fq) const {
        const int pm = u.i0, pn = u.i1;
#pragma unroll
        for (int ai = 0; ai < 2; ++ai)
#pragma unroll
            for (int m = 0; m < 4; ++m) { const int row = pm * 256 + ai * 128 + wr * 64 + m * 16 + fr, b = row >> 12;
#pragma unroll
                for (int bj = 0; bj < 2; ++bj)
#pragma unroll
                    for (int n = 0; n < 2; ++n) { const int col = pn * 256 + bj * 128 + wc * 32 + 16 * n + 4 * fq;
                        const f32x4 xv = *(const f32x4*)(x + (size_t)row * D + col), gt = *(const f32x4*)(mod + b * 6144 + 2048 + col);
                        *(f32x4*)(h + (size_t)row * D + col) = xv + gt * acc[ai][bj][m][n]; } }
    }
};
template <int GATHER, int NCOL, int LDA>
struct SchedMoe {
    volatile LAS unsigned* tb; int G, c; unsigned char* ws;
    __device__ __forceinline__ bool next(int i, GUnit& u) const {
        const int L = i * G + c, NT = (int)tb[32]; if (L >= NT * NCOL) return false;
        const int tau = L / NCOL, pn = L - tau * NCOL; int e = 0;
        for (int q = 1; q < 32; ++q) e += ((int)tb[q] <= tau) ? 1 : 0;
        const int rt = tau - (int)tb[e];
        u.i0 = tau; u.i1 = pn; u.i2 = e; u.i3 = rt;
        if (GATHER) { u.A = (const char*)(ws + WS_AIN); u.B = (const char*)(ws + WS_WGU) + (size_t)e * (512 * D * 2) + (size_t)pn * 256 * LDA * 2; }
        else { u.A = (const char*)(ws + WS_ACT) + (size_t)tau * 256 * LDA * 2; u.B = (const char*)(ws + WS_WD) + (size_t)e * (D * DE * 2) + (size_t)pn * 256 * LDA * 2; }
        return true; }
    __device__ __forceinline__ unsigned arow(const GUnit& u, int r) const {
        if (!GATHER) return (unsigned)(r * LDA) * 2u;
        const int e = u.i2, sl = u.i3 * 256 + r; const unsigned n = ((const unsigned*)(ws + WS_CTL))[CW_CNT + 64 * e];
        const unsigned tok = (unsigned)sl < n ? (((const unsigned*)(ws + WS_LTOK))[(size_t)e * CAP + sl] & 0x7fffffffu) : 0u;
        return tok * (unsigned)(LDA * 2); }
};
struct EpiGateUp {
    static constexpr bool PERM = true;
    bf16* act;
    __device__ __forceinline__ void operator()(const f32x4 (&acc)[2][2][4][2], const GUnit& u, int wr, int wc, int fr, int fq) const {
        const int tau = u.i0, pn = u.i1;
#pragma unroll
        for (int ai = 0; ai < 2; ++ai)
#pragma unroll
            for (int m = 0; m < 4; ++m) { const int row = tau * 256 + ai * 128 + wr * 64 + m * 16 + fr, col = pn * 128 + wc * 32 + 8 * fq;
                const f32x4 g0 = acc[ai][0][m][0], g1 = acc[ai][0][m][1], u0 = acc[ai][1][m][0], u1 = acc[ai][1][m][1];
                u32x4 w; w.x = pg8::cvt_pk_bf16(siluf_(g0[0]) * u0[0], siluf_(g0[1]) * u0[1]); w.y = pg8::cvt_pk_bf16(siluf_(g0[2]) * u0[2], siluf_(g0[3]) * u0[3]);
                w.z = pg8::cvt_pk_bf16(siluf_(g1[0]) * u1[0], siluf_(g1[1]) * u1[1]); w.w = pg8::cvt_pk_bf16(siluf_(g1[2]) * u1[2], siluf_(g1[3]) * u1[3]);
                *(u32x4*)(act + (size_t)row * DE + col) = w; }
    }
};
struct EpiDown {
    static constexpr bool PERM = true;
    unsigned char* ws;
    __device__ __forceinline__ void operator()(const f32x4 (&acc)[2][2][4][2], const GUnit& u, int wr, int wc, int fr, int fq) const {
        const int pn = u.i1, e = u.i2, rt = u.i3; const unsigned n = ((const unsigned*)(ws + WS_CTL))[CW_CNT + 64 * e];
        const unsigned cbase = (unsigned)(pn * 256 + wc * 32 + 8 * fq);
        const int sl0 = rt * 256 + wr * 64 + fr;
        const unsigned* lt = (const unsigned*)(ws + WS_LTOK) + (size_t)e * CAP + sl0; const float* lwp = (const float*)(ws + WS_LW) + (size_t)e * CAP + sl0;
        bf16* ys = (bf16*)(ws + WS_YSLOT);
#pragma unroll
        for (int ai = 0; ai < 2; ++ai)
#pragma unroll
            for (int m = 0; m < 4; ++m) { const int o = ai * 128 + m * 16;
                const bool ok = (unsigned)(sl0 + o) < n; const int oo = ok ? o : -sl0;
                const unsigned tk = lt[oo]; const float wgt = lwp[oo];
                const unsigned off = ok ? ((tk >> 31) * (unsigned)M + (tk & 0x7fffffffu)) * (unsigned)D + cbase : (unsigned)((WS_DUMP - WS_YSLOT) / 2) + cbase;
#pragma unroll
                for (int bj = 0; bj < 2; ++bj) { const f32x4 v0 = acc[ai][bj][m][0] * wgt, v1 = acc[ai][bj][m][1] * wgt;
                    u32x4 w; w.x = pg8::cvt_pk_bf16(v0[0], v0[1]); w.y = pg8::cvt_pk_bf16(v0[2], v0[3]); w.z = pg8::cvt_pk_bf16(v1[0], v1[1]); w.w = pg8::cvt_pk_bf16(v1[2], v1[3]);
                    *(u32x4*)(ys + off + bj * 128) = w; }
                asm volatile("" ::: "memory"); }
    }
};

__device__ __forceinline__ void s5_state_unit(Frame& F, int unit) {
    const int b = unit >> 5, g = unit & 31, lane = F.lane, li = lane & 15, lq = lane >> 4;
    bf16* ay = WSP(bf16, WS_AY) + ((size_t)g * 1024 + b * 256) * KY;
    const bf16* wzt = WSP(bf16, WS_WZT) + (size_t)g * 128 * 256;
    LAS float* zb = (LAS float*)F.lds;
    LAS bf16* wl = (LAS bf16*)F.lds;
#pragma unroll
    for (int i = 0; i < 8; ++i) { const int idx = F.tid + 512 * i, n = idx >> 5, kc = idx & 31; *(LAS u32x4*)(wl + n * 264 + kc * 8) = *(const u32x4*)(wzt + (size_t)n * 256 + kc * 8); }
    bf16x8 af[2][8];
#pragma unroll
    for (int r = 0; r < 2; ++r)
#pragma unroll
        for (int ks = 0; ks < 8; ++ks) af[r][ks] = *(const bf16x8*)(ay + (size_t)((2 * F.wave + r) * 16 + li) * KY + ks * 32 + lq * 8);
    __syncthreads();
    f32x4 acc[2][8];
#pragma unroll
    for (int r = 0; r < 2; ++r)
#pragma unroll
        for (int c = 0; c < 8; ++c) acc[r][c] = (f32x4){0.f, 0.f, 0.f, 0.f};
#pragma unroll
    for (int ks = 0; ks < 8; ++ks) {
#pragma unroll
        for (int c = 0; c < 8; ++c) { const bf16x8 bfr = *(const LAS bf16x8*)(wl + (c * 16 + li) * 264 + ks * 32 + lq * 8);
#pragma unroll
            for (int r = 0; r < 2; ++r) acc[r][c] = mma16(af[r][ks], bfr, acc[r][c]); }
    }
    __syncthreads();
#pragma unroll
    for (int r = 0; r < 2; ++r)
#pragma unroll
        for (int c = 0; c < 8; ++c)
#pragma unroll
            for (int q = 0; q < 4; ++q) zb[((2 * F.wave + r) * 16 + lq * 4 + q) * 129 + c * 16 + li] = acc[r][c][q];
    __syncthreads();
    if (F.wave == 0) {
        const float* l16 = WSP(float, WS_LAM16) + (g * 64 + lane) * 2; const float Lr = l16[0], Li = l16[1];
        float sr = 0.f, si = 0.f;
#pragma unroll 8
        for (int c = 0; c < NCH; ++c) {
            ay[(size_t)c * KY + 256 + lane] = (bf16)f2bf(sr); ay[(size_t)c * KY + 320 + lane] = (bf16)f2bf(si);
            const float zr = zb[c * 129 + lane], zi = zb[c * 129 + 64 + lane];
            const float nr = Lr * sr - Li * si + zr, ni = Lr * si + Li * sr + zi; sr = nr; si = ni;
        }
    }
    __syncthreads();
}

constexpr int PQ = 0, PK = 17408, PKB = 34816, PVB = 53248, PKT = 71680, PL = 90112, PT = 107520, PG = 116736, PB = 116992;
__device__ __forceinline__ void gdn_prep_unit(Frame& F, int unit) {
    const int bh = unit >> 6, n = unit & 63, b = bh >> 2, h = bh & 3, tid = F.tid, lane = F.lane, wave = F.wave, li = lane & 15, lq = lane >> 4;
    const int tok0 = b * SEQ + n * GC;
    const bf16* qkv = WSP(bf16, WS_QKV); const float* convw = F.in[I_CONVW];
    LAS bf16* Qs = (LAS bf16*)(F.lds + PQ); LAS bf16* Ks = (LAS bf16*)(F.lds + PK); LAS bf16* KbT = (LAS bf16*)(F.lds + PKB); LAS bf16* VbT = (LAS bf16*)(F.lds + PVB);
    LAS bf16* KtT = (LAS bf16*)(F.lds + PKT); LAS float* Lm = (LAS float*)(F.lds + PL); LAS bf16* Tm = (LAS bf16*)(F.lds + PT); LAS float* Gs = (LAS float*)(F.lds + PG); LAS float* Bs = (LAS float*)(F.lds + PB);
    unsigned char* cha = F.ws + WS_CHA + (size_t)unit * CHA_BYTES;
    if (wave == 0) { float gv = WSP(float, WS_GG)[(size_t)(tok0 + lane) * 4 + h]; const float bv = WSP(float, WS_BETA)[(size_t)(tok0 + lane) * 4 + h];
#pragma unroll
        for (int d = 1; d < 64; d <<= 1) { const float o = __shfl_up(gv, d); if (lane >= d) gv += o; }
        Gs[lane] = gv; Bs[lane] = bv; if (lane == 63) WSP(float, WS_GL)[unit] = __expf(gv); }
    __syncthreads();
    { const int r = tid >> 3, seg = tid & 7, tl = n * GC + r;
      const float Gr = Gs[r], G63 = Gs[63], br = Bs[r], eg = __expf(Gr);
#pragma unroll
      for (int mat = 0; mat < 3; ++mat) {
          const int colq = mat * 512 + h * 128 + seg * 16;
          float a[16];
#pragma unroll
          for (int c = 0; c < 16; ++c) a[c] = 0.f;
#pragma unroll
          for (int j = 0; j < 4; ++j) { if (tl - 3 + j >= 0) { const bf16* xp = qkv + (size_t)(tok0 + r - 3 + j) * 1536 + colq; const u32x4 x0 = *(const u32x4*)xp, x1 = *(const u32x4*)(xp + 8);
                  const float* wp = convw + j * 1536 + colq; const f32x4 w0 = *(const f32x4*)wp, w1 = *(const f32x4*)(wp + 4), w2 = *(const f32x4*)(wp + 8), w3 = *(const f32x4*)(wp + 12);
                  a[0] += w0[0] * bflo(x0.x); a[1] += w0[1] * bfhi(x0.x); a[2] += w0[2] * bflo(x0.y); a[3] += w0[3] * bfhi(x0.y);
                  a[4] += w1[0] * bflo(x0.z); a[5] += w1[1] * bfhi(x0.z); a[6] += w1[2] * bflo(x0.w); a[7] += w1[3] * bfhi(x0.w);
                  a[8] += w2[0] * bflo(x1.x); a[9] += w2[1] * bfhi(x1.x); a[10] += w2[2] * bflo(x1.y); a[11] += w2[3] * bfhi(x1.y);
                  a[12] += w3[0] * bflo(x1.z); a[13] += w3[1] * bfhi(x1.z); a[14] += w3[2] * bflo(x1.w); a[15] += w3[3] * bfhi(x1.w); } }
          float ss = 0.f;
#pragma unroll
          for (int c = 0; c < 16; ++c) { a[c] = siluf_(a[c]); ss += a[c] * a[c]; }
          if (mat < 2) { ss += __shfl_xor(ss, 1); ss += __shfl_xor(ss, 2); ss += __shfl_xor(ss, 4);
              const float rn = (1.f / sqrtf(ss + EPS)) * (mat == 0 ? 0.08838834764831845f : 1.f);
#pragma unroll
              for (int c = 0; c < 16; ++c) a[c] *= rn; }
          if (mat == 0) {
              u32x4 w0, w1; w0.x = pk2(a[0], a[1]); w0.y = pk2(a[2], a[3]); w0.z = pk2(a[4], a[5]); w0.w = pk2(a[6], a[7]); w1.x = pk2(a[8], a[9]); w1.y = pk2(a[10], a[11]); w1.z = pk2(a[12], a[13]); w1.w = pk2(a[14], a[15]);
              *(LAS u32x4*)(Qs + r * 136 + seg * 16) = w0; *(LAS u32x4*)(Qs + r * 136 + seg * 16 + 8) = w1;
              bf16* qd = (bf16*)(cha + 16384);
#pragma unroll
              for (int gc = 0; gc < 4; ++gc) { u32x2 w; w.x = pk2(a[4 * gc] * eg, a[4 * gc + 1] * eg); w.y = pk2(a[4 * gc + 2] * eg, a[4 * gc + 3] * eg);
                  *(u32x2*)(qd + ((size_t)(((r >> 4) * 4 + (seg >> 1)) * 64 + gc * 16 + (r & 15))) * 8 + (seg & 1) * 4) = w; }
          } else if (mat == 1) {
              u32x4 w0, w1; w0.x = pk2(a[0], a[1]); w0.y = pk2(a[2], a[3]); w0.z = pk2(a[4], a[5]); w0.w = pk2(a[6], a[7]); w1.x = pk2(a[8], a[9]); w1.y = pk2(a[10], a[11]); w1.z = pk2(a[12], a[13]); w1.w = pk2(a[14], a[15]);
              *(LAS u32x4*)(Ks + r * 136 + seg * 16) = w0; *(LAS u32x4*)(Ks + r * 136 + seg * 16 + 8) = w1;
              const float s1 = br * eg, s2 = __expf(G63 - Gr);
#pragma unroll
              for (int c = 0; c < 16; ++c) { KbT[(seg * 16 + c) * 72 + (r ^ (seg << 3))] = (bf16)f2bf(a[c] * s1); KtT[(seg * 16 + c) * 72 + (r ^ (seg << 3))] = (bf16)f2bf(a[c] * s2); }
          } else {
#pragma unroll
              for (int c = 0; c < 16; ++c) VbT[(seg * 16 + c) * 72 + (r ^ (seg << 3))] = (bf16)f2bf(a[c] * br);
          }
      }
    }
    __syncthreads();
    { const int tt = wave & 3; const bool iskk = wave >= 4;
      LAS bf16* Bsrc = iskk ? Ks : Qs;
      f32x4 d[4];
#pragma unroll
      for (int st = 0; st < 4; ++st) d[st] = (f32x4){0.f, 0.f, 0.f, 0.f};
#pragma unroll
      for (int ks = 0; ks < 4; ++ks) { const bf16x8 bf = *(const LAS bf16x8*)(Bsrc + (tt * 16 + li) * 136 + ks * 32 + lq * 8);
#pragma unroll
          for (int st = 0; st < 4; ++st) { const bf16x8 af = *(const LAS bf16x8*)(Ks + (st * 16 + li) * 136 + ks * 32 + lq * 8); d[st] = mma16(af, bf, d[st]); } }
      const int t = tt * 16 + li; const float Gt = Gs[t], bti = Bs[t];
      if (!iskk) { bf16* qk = (bf16*)(cha + 49152);
#pragma unroll
          for (int ks = 0; ks < 2; ++ks) { float v[8];
#pragma unroll
              for (int hh = 0; hh < 2; ++hh)
#pragma unroll
                  for (int r = 0; r < 4; ++r) { const int s = (2 * ks + hh) * 16 + 4 * lq + r; v[hh * 4 + r] = (s <= t) ? d[2 * ks + hh][r] * __expf(Gt - Gs[s]) : 0.f; }
              u32x4 w; w.x = pk2(v[0], v[1]); w.y = pk2(v[2], v[3]); w.z = pk2(v[4], v[5]); w.w = pk2(v[6], v[7]);
              *(u32x4*)(qk + ((size_t)((tt * 2 + ks) * 64 + lane)) * 8) = w; }
      } else {
#pragma unroll
          for (int st = 0; st < 4; ++st) { f32x4 v;
#pragma unroll
              for (int r = 0; r < 4; ++r) { const int j = st * 16 + 4 * lq + r; v[r] = (t > j) ? bti * d[st][r] * __expf(Gt - Gs[j]) : 0.f; }
              *(LAS f32x4*)(Lm + t * 68 + st * 16 + 4 * lq) = v; }
      }
    }
    __syncthreads();
    { const int cl = lane >> 3, kk = lane & 7, c = wave * 8 + cl;
      float Tr[8];
#pragma unroll
      for (int m = 0; m < 8; ++m) Tr[m] = 0.f;
#pragma unroll
      for (int i = 0; i < 64; ++i) { float s = 0.f, s_b = 0.f;
#pragma unroll
          for (int m = 0; m < 8; ++m) if (8 * m < i) { if (m & 1) s_b += Lm[i * 68 + 8 * m + kk] * Tr[m]; else s += Lm[i * 68 + 8 * m + kk] * Tr[m]; }
          s = dpp_add8(s + s_b);
          const float tv = (i == c ? 1.f : 0.f) - s;
          if (kk == (i & 7)) Tr[i >> 3] = tv; }
#pragma unroll
      for (int m = 0; m < 8; ++m) Tm[(8 * m + kk) * 72 + c] = (bf16)f2bf(Tr[m]);
    }
    __syncthreads();
    { bf16x8 tf[4][2];
#pragma unroll
      for (int tt = 0; tt < 4; ++tt)
#pragma unroll
          for (int ks = 0; ks < 2; ++ks) tf[tt][ks] = *(const LAS bf16x8*)(Tm + (tt * 16 + li) * 72 + ks * 32 + lq * 8);
      bf16x8 vf[2], kf[2];
#pragma unroll
      for (int ks = 0; ks < 2; ++ks) { vf[ks] = *(const LAS bf16x8*)(VbT + (wave * 16 + li) * 72 + ((ks * 32 + lq * 8) ^ (wave << 3))); kf[ks] = *(const LAS bf16x8*)(KbT + (wave * 16 + li) * 72 + ((ks * 32 + lq * 8) ^ (wave << 3))); }
      f32x4* vald = (f32x4*)(F.ws + WS_VALD + (size_t)unit * 32768);
      bf16* nkc = (bf16*)cha;
#pragma unroll
      for (int tt = 0; tt < 4; ++tt) {
          f32x4 dv = (f32x4){0.f, 0.f, 0.f, 0.f}, dk = (f32x4){0.f, 0.f, 0.f, 0.f};
#pragma unroll
          for (int ks = 0; ks < 2; ++ks) { dv = mma16(tf[tt][ks], vf[ks], dv); dk = mma16(kf[ks], tf[tt][ks], dk); }
          vald[(wave * 4 + tt) * 64 + lane] = dv;
          u32x2 w; w.x = pk2(-dk[0], -dk[1]); w.y = pk2(-dk[2], -dk[3]);
          *(u32x2*)(nkc + ((size_t)((tt * 4 + (wave >> 1)) * 64 + lane)) * 8 + (wave & 1) * 4) = w;
      }
      bf16* ktg = (bf16*)(cha + 32768);
#pragma unroll
      for (int f = 0; f < 2; ++f) { const int fi = wave * 2 + f, mt = fi >> 1, ks = fi & 1;
          const u32x2 lo = *(const LAS u32x2*)(KtT + (mt * 16 + li) * 72 + ((ks * 32 + 4 * lq) ^ (mt << 3))), hi = *(const LAS u32x2*)(KtT + (mt * 16 + li) * 72 + ((ks * 32 + 16 + 4 * lq) ^ (mt << 3)));
          u32x4 w; w.x = lo.x; w.y = lo.y; w.z = hi.x; w.w = hi.y;
          *(u32x4*)(ktg + ((size_t)(fi * 64 + lane)) * 8) = w; }
    }
    __syncthreads();
}

__device__ __forceinline__ void gdn_seq(Frame& F, int wgi) {
    const int bh = wgi >> 1, half = wgi & 1, b = bh >> 2, h = bh & 3, wave = F.wave, lane = F.lane, li = lane & 15, lq = lane >> 4;
    const unsigned char* cha = F.ws + WS_CHA + (size_t)bh * 64 * CHA_BYTES;
    const float* glp = WSP(float, WS_GL) + bh * 64;
    LAS unsigned char* buf = F.lds;
    if (wave >= 4) {
        const int lt = F.tid - 256;
        u32x4 rg[14];
#pragma unroll
        for (int k = 0; k < 14; ++k) rg[k] = *(const u32x4*)(cha + (size_t)(lt + 256 * k) * 16);
#pragma unroll
        for (int k = 0; k < 14; ++k) *(LAS u32x4*)(buf + (lt + 256 * k) * 16) = rg[k];
#pragma unroll
        for (int k = 0; k < 14; ++k) rg[k] = *(const u32x4*)(cha + CHA_BYTES + (size_t)(lt + 256 * k) * 16);
        __syncthreads();
        for (int n = 0; n < 64; ++n) {
            if (n + 1 < 64) {
#pragma unroll
                for (int k = 0; k < 14; ++k) *(LAS u32x4*)(buf + ((n + 1) & 1) * CHA_BYTES + (lt + 256 * k) * 16) = rg[k];
                if (n + 2 < 64) {
#pragma unroll
                    for (int k = 0; k < 14; ++k) rg[k] = *(const u32x4*)(cha + (size_t)(n + 2) * CHA_BYTES + (size_t)(lt + 256 * k) * 16);
                }
            }
            __syncthreads();
        }
    } else {
        const int sl = half * 4 + wave;
        const f32x4* vald = (const f32x4*)(F.ws + WS_VALD + (size_t)bh * 64 * 32768) + sl * 256 + lane;
        float* og = WSP(float, WS_O) + (size_t)(b * SEQ) * 512 + h * 128 + sl * 16 + li;
        f32x4 S[8];
#pragma unroll
        for (int d = 0; d < 8; ++d) S[d] = (f32x4){0.f, 0.f, 0.f, 0.f};
        f32x4 vn[4];
#pragma unroll
        for (int tt = 0; tt < 4; ++tt) vn[tt] = vald[tt * 64];
        float gln = glp[0];
        __syncthreads();
        for (int n = 0; n < 64; ++n) {
            const LAS unsigned char* bb = buf + (n & 1) * CHA_BYTES + lane * 16;
            f32x4 W[4]; const float gl = gln;
#pragma unroll
            for (int tt = 0; tt < 4; ++tt) W[tt] = vn[tt];
            if (n + 1 < 64) {
#pragma unroll
                for (int tt = 0; tt < 4; ++tt) vn[tt] = vald[(size_t)(n + 1) * 2048 + tt * 64];
                gln = glp[n + 1];
            }
            bf16x8 Sb[4];
#pragma unroll
            for (int ks = 0; ks < 4; ++ks) Sb[ks] = pack8(S[2 * ks], S[2 * ks + 1]);
            f32x4 O[4];
#pragma unroll
            for (int tt = 0; tt < 4; ++tt) { O[tt] = (f32x4){0.f, 0.f, 0.f, 0.f};
#pragma unroll
                for (int ks = 0; ks < 4; ++ks) { const bf16x8 a = *(const LAS bf16x8*)(bb + (tt * 4 + ks) * 1024); W[tt] = mma16(a, Sb[ks], W[tt]);
                    const bf16x8 q = *(const LAS bf16x8*)(bb + 16384 + (tt * 4 + ks) * 1024); O[tt] = mma16(q, Sb[ks], O[tt]); } }
            bf16x8 Vb[2];
#pragma unroll
            for (int ks = 0; ks < 2; ++ks) Vb[ks] = pack8(W[2 * ks], W[2 * ks + 1]);
#pragma unroll
            for (int tt = 0; tt < 4; ++tt)
#pragma unroll
                for (int ks = 0; ks < 2; ++ks) { const bf16x8 a = *(const LAS bf16x8*)(bb + 49152 + (tt * 2 + ks) * 1024); O[tt] = mma16(a, Vb[ks], O[tt]); }
#pragma unroll
            for (int d = 0; d < 8; ++d) { S[d] = S[d] * gl;
#pragma unroll
                for (int ks = 0; ks < 2; ++ks) { const bf16x8 a = *(const LAS bf16x8*)(bb + 32768 + (d * 2 + ks) * 1024); S[d] = mma16(a, Vb[ks], S[d]); } }
            float* op = og + (size_t)(n * GC) * 512;
#pragma unroll
            for (int tt = 0; tt < 4; ++tt)
#pragma unroll
                for (int r = 0; r < 4; ++r) op[(size_t)(tt * 16 + 4 * lq + r) * 512] = O[tt][r];
            __syncthreads();
        }
    }
}

__device__ __forceinline__ void gdn_out(Frame& F, int c, int G) {
    const float* o = WSP(float, WS_O); const bf16* z = WSP(bf16, WS_Z); bf16* cc = WSP(bf16, WS_AIN); const float* gn = F.in[I_GNG];
    const int seg = F.tid & 7;
    f32x4 gv[4];
#pragma unroll
    for (int j = 0; j < 4; ++j) gv[j] = *(const f32x4*)(gn + seg * 16 + 4 * j);
    for (int it = c; it < M * NH / 64; it += G) {
        const int p = it * 64 + (F.tid >> 3), tok = p >> 2, hh = p & 3;
        const float* op = o + (size_t)tok * 512 + hh * 128 + seg * 16;
        f32x4 v[4]; float ss = 0.f;
#pragma unroll
        for (int j = 0; j < 4; ++j) { v[j] = *(const f32x4*)(op + 4 * j); ss += (v[j].x * v[j].x + v[j].y * v[j].y) + (v[j].z * v[j].z + v[j].w * v[j].w); }
        ss += __shfl_xor(ss, 1); ss += __shfl_xor(ss, 2); ss += __shfl_xor(ss, 4);
        const float rstd = 1.f / sqrtf(ss * (1.f / 128.f) + EPS);
        const bf16* zp = z + (size_t)tok * 512 + hh * 128 + seg * 16; const u32x4 z0 = *(const u32x4*)zp, z1 = *(const u32x4*)(zp + 8);
        float zz[16] = {bflo(z0.x), bfhi(z0.x), bflo(z0.y), bfhi(z0.y), bflo(z0.z), bfhi(z0.z), bflo(z0.w), bfhi(z0.w), bflo(z1.x), bfhi(z1.x), bflo(z1.y), bfhi(z1.y), bflo(z1.z), bfhi(z1.z), bflo(z1.w), bfhi(z1.w)};
        float r[16];
#pragma unroll
        for (int j = 0; j < 4; ++j)
#pragma unroll
            for (int q = 0; q < 4; ++q) r[4 * j + q] = v[j][q] * rstd * gv[j][q] * siluf_(zz[4 * j + q]);
        u32x4 w0, w1; w0.x = pk2(r[0], r[1]); w0.y = pk2(r[2], r[3]); w0.z = pk2(r[4], r[5]); w0.w = pk2(r[6], r[7]); w1.x = pk2(r[8], r[9]); w1.y = pk2(r[10], r[11]); w1.z = pk2(r[12], r[13]); w1.w = pk2(r[14], r[15]);
        bf16* dp = cc + (size_t)tok * D + 512 + hh * 128 + seg * 16; *(u32x4*)dp = w0; *(u32x4*)(dp + 8) = w1;
    }
}

constexpr int RT_AHI = 0, RT_ALO = 33024, RT_P = 66048, RT_LG = 90624, RT_ASTR = 1032;
__device__ __forceinline__ void p7_route(Frame& F) {
    const float* hbuf = F.out; const float* g2 = F.in[I_N2G]; const float* mod = WSP(float, WS_MOD);
    const int lane = F.lane, wave = F.wave, li = lane & 15, lq = lane >> 4;
    LAS bf16* Ahi = (LAS bf16*)(F.lds + RT_AHI); LAS bf16* Alo = (LAS bf16*)(F.lds + RT_ALO); LAS float* P = (LAS float*)(F.lds + RT_P); LAS float* Lg = (LAS float*)(F.lds + RT_LG);
    bf16x8 bhi[4][3], blo[4][3];
    { const float* wg = F.in[I_WRG]; const float* we = F.in[I_WRE];
#pragma unroll
      for (int kk = 0; kk < 4; ++kk)
#pragma unroll
          for (int ct = 0; ct < 3; ++ct) { const int col = ct * 16 + li; float w[8];
#pragma unroll
              for (int j = 0; j < 8; ++j) { const int k = 32 * (4 * wave + kk) + 8 * lq + j; w[j] = col < 4 ? wg[k * 4 + col] : (col < 36 ? we[k * 32 + col - 4] : 0.f); }
              u32x4 h, l; unsigned hb[8];
#pragma unroll
              for (int j = 0; j < 8; ++j) hb[j] = f2bf(w[j]);
              h.x = hb[0] | (hb[1] << 16); h.y = hb[2] | (hb[3] << 16); h.z = hb[4] | (hb[5] << 16); h.w = hb[6] | (hb[7] << 16);
              l.x = pk2(w[0] - bf2f((unsigned short)hb[0]), w[1] - bf2f((unsigned short)hb[1])); l.y = pk2(w[2] - bf2f((unsigned short)hb[2]), w[3] - bf2f((unsigned short)hb[3]));
              l.z = pk2(w[4] - bf2f((unsigned short)hb[4]), w[5] - bf2f((unsigned short)hb[5])); l.w = pk2(w[6] - bf2f((unsigned short)hb[6]), w[7] - bf2f((unsigned short)hb[7]));
              bhi[kk][ct] = __builtin_bit_cast(bf16x8, h); blo[kk][ct] = __builtin_bit_cast(bf16x8, l); } }
    bf16* min_ = WSP(bf16, WS_AIN); unsigned* cnt = (unsigned*)(F.ws + WS_CTL) + CW_CNT; unsigned* ltok = WSP(unsigned, WS_LTOK); float* lw = WSP(float, WS_LW);
    const int ntile = M / 16;
    LAS unsigned* RtE = (LAS unsigned*)(F.lds + RT_LG + 3072); LAS float* RtW = (LAS float*)(RtE + 128); LAS unsigned* RtM = RtE + 256; LAS unsigned* RtC = RtE + 320; LAS unsigned* RtB = RtE + 352;
    if (F.tid < 32) RtC[F.tid] = 0u;
    int nloc = 0;
    f32x4 vnx[2][4];
    if (F.vcu < ntile) {
#pragma unroll
        for (int rr = 0; rr < 2; ++rr) { const f32x4* xr = (const f32x4*)(hbuf + (size_t)(F.vcu * 16 + wave * 2 + rr) * D) + lane;
#pragma unroll
            for (int j = 0; j < 4; ++j) vnx[rr][j] = xr[64 * j]; } }
    for (int tile = F.vcu; tile < ntile; tile += F.G) {
        const int b = (tile * 16) >> 12; nloc += 16;
#pragma unroll
        for (int rr = 0; rr < 2; ++rr) { const int r = wave * 2 + rr, m = tile * 16 + r;
            f32x4 v[4]; float ss = 0.f;
#pragma unroll
            for (int j = 0; j < 4; ++j) { v[j] = vnx[rr][j]; ss += (v[j].x * v[j].x + v[j].y * v[j].y) + (v[j].z * v[j].z + v[j].w * v[j].w); }
            const float rstd = 1.f / sqrtf(wave_sum(ss) * (1.f / D) + EPS);
            u32x2* o8 = (u32x2*)(min_ + (size_t)m * D) + lane;
#pragma unroll
            for (int j = 0; j < 4; ++j) { const int k = 4 * lane + 256 * j;
                const f32x4 gv = *(const f32x4*)(g2 + k), sh = *(const f32x4*)(mod + b * 6144 + 3072 + k), sc = *(const f32x4*)(mod + b * 6144 + 4096 + k);
                const f32x4 a = v[j] * rstd * gv * (sc + 1.f) + sh;
                const unsigned h0 = f2bf(a.x), h1 = f2bf(a.y), h2 = f2bf(a.z), h3 = f2bf(a.w);
                u32x2 wh; wh.x = h0 | (h1 << 16); wh.y = h2 | (h3 << 16); o8[64 * j] = wh;
                u32x2 wl; wl.x = pk2(a.x - bf2f((unsigned short)h0), a.y - bf2f((unsigned short)h1)); wl.y = pk2(a.z - bf2f((unsigned short)h2), a.w - bf2f((unsigned short)h3));
                *(LAS u32x2*)(Ahi + r * RT_ASTR + k) = wh; *(LAS u32x2*)(Alo + r * RT_ASTR + k) = wl; } }
        if (tile + F.G < ntile) {
#pragma unroll
            for (int rr = 0; rr < 2; ++rr) { const f32x4* xr = (const f32x4*)(hbuf + (size_t)((tile + F.G) * 16 + wave * 2 + rr) * D) + lane;
#pragma unroll
                for (int j = 0; j < 4; ++j) vnx[rr][j] = xr[64 * j]; } }
        __syncthreads();
        f32x4 acc[3];
#pragma unroll
        for (int ct = 0; ct < 3; ++ct) acc[ct] = (f32x4){0.f, 0.f, 0.f, 0.f};
#pragma unroll
        for (int kk = 0; kk < 4; ++kk) { const int ko = 32 * (4 * wave + kk) + 8 * lq;
            const bf16x8 ah = *(const LAS bf16x8*)(Ahi + li * RT_ASTR + ko), al = *(const LAS bf16x8*)(Alo + li * RT_ASTR + ko);
#pragma unroll
            for (int ct = 0; ct < 3; ++ct) { acc[ct] = mma16(ah, bhi[kk][ct], acc[ct]); acc[ct] = mma16(al, bhi[kk][ct], acc[ct]); acc[ct] = mma16(ah, blo[kk][ct], acc[ct]); } }
#pragma unroll
        for (int ct = 0; ct < 3; ++ct) *(LAS f32x4*)(P + ((wave * 3 + ct) * 64 + lane) * 4) = acc[ct];
        __syncthreads();
        for (int o = F.tid; o < 768; o += 512) { const int row = o / 48, col = o - row * 48, ct = col >> 4, l2 = (row >> 2) * 16 + (col & 15), r2 = row & 3; float sacc = 0.f;
#pragma unroll
            for (int w = 0; w < 8; ++w) sacc += P[((w * 3 + ct) * 64 + l2) * 4 + r2];
            Lg[o] = sacc; }
        __syncthreads();
        if (F.tid < 16) { const int m = tile * 16 + F.tid; const LAS float* lg = Lg + F.tid * 48;
            int grp = 0; float gm = lg[0];
#pragma unroll
            for (int q = 1; q < 4; ++q) if (lg[q] > gm) { gm = lg[q]; grp = q; }
            float den = 0.f;
#pragma unroll
            for (int q = 0; q < 4; ++q) den += expf(lg[q] - gm);
            const float pgrp = 1.f / den;
            float sv[8];
#pragma unroll
            for (int q = 0; q < 8; ++q) sv[q] = lg[4 + grp * 8 + q];
            int i1 = 0; float v1 = sv[0];
#pragma unroll
            for (int q = 1; q < 8; ++q) if (sv[q] > v1) { v1 = sv[q]; i1 = q; }
            int i2 = -1; float v2 = -3.4e38f;
#pragma unroll
            for (int q = 0; q < 8; ++q) if (q != i1 && sv[q] > v2) { v2 = sv[q]; i2 = q; }
            const float e2 = expf(v2 - v1), w1 = pgrp / (1.f + e2), w2 = pgrp * e2 / (1.f + e2);
            const int ex1 = grp * 8 + i1, ex2 = grp * 8 + i2, lr = ((tile - F.vcu) / F.G) * 16 + F.tid;
            if (lr < 64) { RtE[2 * lr] = (unsigned)ex1; RtE[2 * lr + 1] = (unsigned)ex2; RtW[2 * lr] = w1; RtW[2 * lr + 1] = w2; RtM[lr] = (unsigned)m; }
            else {
                const unsigned s1 = __hip_atomic_fetch_add(cnt + 64 * ex1, 1u, __ATOMIC_RELAXED, __HIP_MEMORY_SCOPE_AGENT);
                const unsigned s2 = __hip_atomic_fetch_add(cnt + 64 * ex2, 1u, __ATOMIC_RELAXED, __HIP_MEMORY_SCOPE_AGENT);
                ltok[(size_t)ex1 * CAP + s1] = (unsigned)m; lw[(size_t)ex1 * CAP + s1] = w1;
                ltok[(size_t)ex2 * CAP + s2] = (unsigned)m | 0x80000000u; lw[(size_t)ex2 * CAP + s2] = w2; } }
    }
    __syncthreads();
    if (nloc > 64) nloc = 64;
    unsigned rank = 0u, ex = 0u;
    if (F.tid < 2 * nloc) { ex = RtE[F.tid]; rank = __hip_atomic_fetch_add((LAS unsigned*)&RtC[ex], 1u, __ATOMIC_RELAXED, __HIP_MEMORY_SCOPE_WORKGROUP); }
    __syncthreads();
    if (F.tid < 32) { const unsigned c = RtC[F.tid]; RtB[F.tid] = c ? __hip_atomic_fetch_add(cnt + 64 * F.tid, c, __ATOMIC_RELAXED, __HIP_MEMORY_SCOPE_AGENT) : 0u; }
    __syncthreads();
    if (F.tid < 2 * nloc) { const unsigned slot = RtB[ex] + rank; ltok[(size_t)ex * CAP + slot] = RtM[F.tid >> 1] | ((F.tid & 1) ? 0x80000000u : 0u); lw[(size_t)ex * CAP + slot] = RtW[F.tid]; }
    __syncthreads();
}

__device__ __forceinline__ void moe_tile_table(Frame& F) {
    if (F.tid < 64) { const unsigned* cnt = (const unsigned*)(F.ws + WS_CTL) + CW_CNT;
        unsigned nt = F.lane < 32 ? (__hip_atomic_load(cnt + 64 * F.lane, __ATOMIC_RELAXED, __HIP_MEMORY_SCOPE_AGENT) + 255u) >> 8 : 0u;
        unsigned inc = nt;
#pragma unroll
        for (int d = 1; d < 64; d <<= 1) { const unsigned o = __shfl_up(inc, d); if (F.lane >= d) inc += o; }
        if (F.lane < 32) F.MISC[16 + F.lane] = inc - nt;
        if (F.lane == 31) F.MISC[48] = inc; }
    __syncthreads();
}

__device__ __forceinline__ void p10_final(Frame& F) {
    float* out = F.out; const float* mod = WSP(float, WS_MOD); const float* nf = F.in[I_NFG]; const bf16* ys = WSP(bf16, WS_YSLOT);
    const int lane = F.lane, gw = F.vcu * 8 + F.wave, NGW = F.G * 8;
    for (int m = gw; m < M; m += NGW) {
        const int b = m >> 12;
        f32x4* xr = (f32x4*)(out + (size_t)m * D) + lane;
        const u32x2* y0 = (const u32x2*)(ys + (size_t)m * D) + lane; const u32x2* y1 = (const u32x2*)(ys + ((size_t)M + m) * D) + lane;
        f32x4 v[4]; float ss = 0.f;
#pragma unroll
        for (int j = 0; j < 4; ++j) { const int k = 4 * lane + 256 * j; const f32x4 gt = *(const f32x4*)(mod + b * 6144 + 5120 + k); const u32x2 a = y0[64 * j], c = y1[64 * j];
            f32x4 y; y.x = bflo(a.x) + bflo(c.x); y.y = bfhi(a.x) + bfhi(c.x); y.z = bflo(a.y) + bflo(c.y); y.w = bfhi(a.y) + bfhi(c.y);
            v[j] = xr[64 * j] + gt * y; ss += (v[j].x * v[j].x + v[j].y * v[j].y) + (v[j].z * v[j].z + v[j].w * v[j].w); }
        const float rstd = 1.f / sqrtf(wave_sum(ss) * (1.f / D) + EPS);
#pragma unroll
        for (int j = 0; j < 4; ++j) { const f32x4 gv = *(const f32x4*)(nf + 4 * lane + 256 * j); xr[64 * j] = v[j] * rstd * gv; }
    }
}

constexpr int N_PHASES = 11;
__global__ void __launch_bounds__(512, 2) hymba_fwd(Args args) {
    extern __shared__ __attribute__((aligned(16))) unsigned char lds[];
    Frame F;
    F.lds = (LAS unsigned char*)lds; F.MISC = (volatile LAS unsigned*)(F.lds + MISC_OFF);
    F.tid = threadIdx.x; F.lane = F.tid & 63; F.wave = __builtin_amdgcn_readfirstlane(F.tid >> 6);
    F.G = gridDim.x; { const int bx = blockIdx.x; F.vcu = (F.G % 8 == 0) ? (bx % 8) * (F.G / 8) + bx / 8 : bx; }
#pragma unroll
    for (int i = 0; i < 28; ++i) F.in[i] = args.in[i];
    F.out = args.out; F.ws = args.ws;
    for (int u = F.tid; u < 256; u += 512) F.MISC[u] = 0u;
    __syncthreads();
    XcdBarrier bar; bar.bar = (unsigned*)(F.ws + WS_CTL) + CW_BAR; bar.x = 0; bar.st = nullptr;
    if (MK_N_LAUNCHES == 1) bar = xcd_barrier_post((unsigned*)(F.ws + WS_CTL) + CW_BAR, F.MISC + 8);
    const int lo = args.ph_lo, hi = args.ph_hi;
#ifdef ONLY_PHASE
#define IN(k) ((k) == ONLY_PHASE && lo <= (k) && (k) < hi)
#else
#define IN(k) (lo <= (k) && (k) < hi)
#endif
#ifdef TIME_PHASE
#define TSTAMP(slot) do { if (blockIdx.x == 0 && F.tid == 0) { const unsigned long long t_ = __builtin_amdgcn_s_memrealtime(); F.MISC[60 + 2 * (slot)] = (unsigned)t_; F.MISC[61 + 2 * (slot)] = (unsigned)(t_ >> 32); } } while (0)
#define SEAM(k) do { if ((k) == TIME_PHASE) {} if (IN(k) && IN((k) + 1)) xcd_barrier(bar); if ((k) == TIME_PHASE) TSTAMP(1); if ((k) + 1 == TIME_PHASE) TSTAMP(0); } while (0)
#else
#define SEAM(k) do { if (IN(k) && IN((k) + 1)) xcd_barrier(bar); } while (0)
#endif
#ifdef REP_PHASE
#define REPS(k) for (int rep_ = 0; rep_ < ((k) == REP_PHASE ? 1 + REP_N : 1); ++rep_, (void)((k) == REP_PHASE && rep_ <= REP_N ? (xcd_barrier(bar), 0) : 0))
#else
#define REPS(k)
#endif
    const int bx = (int)blockIdx.x;
#ifdef EXTRA_BARS
    for (int eb_ = 0; eb_ < EXTRA_BARS; ++eb_) xcd_barrier(bar);
#endif

#ifdef TIME_PHASE
    if (TIME_PHASE == 0) TSTAMP(0);
#endif
    if (IN(0)) REPS(0) { p0_prologue(F); } SEAM(0);
    if (IN(1)) REPS(1) { p1_ain(F); } SEAM(1);
    if (IN(2)) REPS(2) {
        SchedDense S; S.T.init(M / 256, N_IN / 256, F.G, bx); S.A = (const char*)WSP(bf16, WS_AIN); S.B = (const char*)WSP(bf16, WS_WIN); S.lda = D; S.ldb = D;
        EpiInProj E{WSP(bf16, WS_AY), WSP(bf16, WS_QKV), WSP(bf16, WS_Z)};
        pg8::gemm_phase<EpiInProj, SchedDense>(F.lds, D, D, S, E);
    } SEAM(2);
    if (IN(3)) REPS(3) {
        unsigned* qh = (unsigned*)(F.ws + WS_CTL) + CW_Q3;
        for (;;) {
            if (F.tid == 0) F.MISC[50] = __hip_atomic_fetch_add(qh, 1u, __ATOMIC_RELAXED, __HIP_MEMORY_SCOPE_AGENT);
            __syncthreads();
            const int u = (int)F.MISC[50];
            __syncthreads();
            if (u >= 128) break;
            s5_state_unit(F, u);
        }
        for (;;) {
            if (F.tid == 0) F.MISC[50] = __hip_atomic_fetch_add(qh + 64, 1u, __ATOMIC_RELAXED, __HIP_MEMORY_SCOPE_AGENT);
            __syncthreads();
            const int u = (int)F.MISC[50];
            __syncthreads();
            if (u >= 1024) break;
            gdn_prep_unit(F, u);
        }
    } SEAM(3);
    if (IN(4)) REPS(4) {
        if ((F.vcu & 7) == 0 && F.vcu < 256) gdn_seq(F, F.vcu >> 3);
        else { SchedS5Y S; S.G = 128; { const int cc = F.vcu - (F.vcu >> 3) - 1; S.c = cc < 128 ? cc : -1; } S.ay = (const char*)WSP(bf16, WS_AY); S.bty = (const char*)WSP(bf16, WS_BTY);
            EpiS5Y E{F.in[I_S5D], WSP(bf16, WS_YG)};
            pg8::gemm_phase<EpiS5Y, SchedS5Y>(F.lds, KY, KY, S, E); }
    } SEAM(4);
    if (IN(5)) REPS(5) {
        const int ng = F.G >= 256 ? 128 : F.G / 2;
        if (F.vcu < ng) { SchedDense S; S.T.init(M / 256, 2, ng, F.vcu); S.A = (const char*)WSP(bf16, WS_YG); S.B = (const char*)WSP(bf16, WS_WGLU); S.lda = 512; S.ldb = 512;
            EpiGlu E{WSP(bf16, WS_YG), F.in[I_BGLU], WSP(bf16, WS_AIN)};
            pg8::gemm_phase<EpiGlu, SchedDense>(F.lds, 512, 512, S, E); }
        else gdn_out(F, F.vcu - ng, F.G - ng);
    } SEAM(5);
    if (IN(6)) REPS(6) {
        SchedDense S; S.T.init(M / 256, D / 256, F.G, bx); S.A = (const char*)WSP(bf16, WS_AIN); S.B = (const char*)WSP(bf16, WS_WOUT); S.lda = D; S.ldb = D;
        EpiOutProj E{F.in[I_X], WSP(float, WS_MOD), F.out};
        pg8::gemm_phase<EpiOutProj, SchedDense>(F.lds, D, D, S, E);
    } SEAM(6);
    if (IN(7)) REPS(7) { p7_route(F); } SEAM(7);
    if (IN(8)) REPS(8) {
        moe_tile_table(F);
        SchedMoe<1, 2, D> S; S.tb = F.MISC + 16; S.G = F.G; S.c = F.vcu; S.ws = F.ws;
        EpiGateUp E{WSP(bf16, WS_ACT)};
        pg8::gemm_phase<EpiGateUp, SchedMoe<1, 2, D>>(F.lds, D, D, S, E);
    } SEAM(8);
    if (IN(9)) REPS(9) {
        moe_tile_table(F);
        SchedMoe<0, 4, DE> S; S.tb = F.MISC + 16; S.G = F.G; S.c = F.vcu; S.ws = F.ws;
        EpiDown E{F.ws};
        pg8::gemm_phase<EpiDown, SchedMoe<0, 4, DE>>(F.lds, DE, DE, S, E);
    } SEAM(9);
    if (IN(10)) REPS(10) { p10_final(F); }
#ifdef TIME_PHASE
    if (TIME_PHASE == 10) { __syncthreads(); TSTAMP(1); }
    if (blockIdx.x == 0 && F.tid == 0) { const unsigned long long t0_ = ((unsigned long long)F.MISC[61] << 32) | F.MISC[60], t1_ = ((unsigned long long)F.MISC[63] << 32) | F.MISC[62];
        const unsigned long long until_ = __builtin_amdgcn_s_memrealtime() + 4ull * (t1_ - t0_);
        while (__builtin_amdgcn_s_memrealtime() < until_) __builtin_amdgcn_s_sleep(8); }
#endif
#undef IN
#undef SEAM
}

extern "C" void kernel_launch(void* const* d_in, const int* in_sizes, int n_in, void* d_out, int out_size, void* d_ws, size_t ws_size, hipStream_t stream) {
    static int grid = 0;
    if (grid == 0) {
        if (n_in != 28 || in_sizes[0] != M * D || out_size != M * D || ws_size < WS_END) { fprintf(stderr, "kernel_launch: unexpected problem (n_in %d, in0 %d, out %d, ws %zu)\n", n_in, n_in > 0 ? in_sizes[0] : -1, out_size, ws_size); grid = -1; return; }
        int dev = 0, cus = 0;
        if (hipGetDevice(&dev) != hipSuccess || hipDeviceGetAttribute(&cus, hipDeviceAttributeMultiprocessorCount, dev) != hipSuccess) { grid = -1; return; }
        if (hipFuncSetAttribute((const void*)hymba_fwd, hipFuncAttributeMaxDynamicSharedMemorySize, LDS_BYTES) != hipSuccess) { fprintf(stderr, "kernel_launch: hipFuncSetAttribute failed\n"); grid = -1; return; }
        int per_cu = 0;
        if (hipOccupancyMaxActiveBlocksPerMultiprocessor(&per_cu, (const void*)hymba_fwd, 512, LDS_BYTES) != hipSuccess || per_cu < 1) fprintf(stderr, "kernel_launch: occupancy query reports %d\n", per_cu);
        (void)hipGetLastError();
        grid = cus;
    }
    if (grid < 0) return;
    if (hipMemsetAsync((char*)d_ws + WS_CTL, 0, CTL_ZERO_BYTES, stream) != hipSuccess) return;
    Args a{};
    for (int i = 0; i < 28; ++i) a.in[i] = (const float*)d_in[i];
    a.out = (float*)d_out; a.ws = (unsigned char*)d_ws;
    if (MK_N_LAUNCHES == 1) { a.ph_lo = 0; a.ph_hi = N_PHASES; hipLaunchKernelGGL(hymba_fwd, dim3(grid), dim3(512), LDS_BYTES, stream, a); }
    else for (int p = 0; p < N_PHASES; ++p) { a.ph_lo = p; a.ph_hi = p + 1; hipLaunchKernelGGL(hymba_fwd, dim3(grid), dim3(512), LDS_BYTES, stream, a); }
}
```
